# Optimizing an MI355X kernel written in HIP

```python
import jax, jax.numpy as jnp
from jax import lax
import numpy as np

D_MODEL = 4096
BATCH = 1
SEQ = 8192
DEPTH = 1

MEM_LEN = 256

POOL_WINDOWS = (2, 4, 8, 16)
POOL_GROUPS = 4
POOL_WIDTH = D_MODEL
POOL_GROUP_DIM = POOL_WIDTH // POOL_GROUPS

RET_QK_DIM = 256
RET_HEADS = D_MODEL // RET_QK_DIM
RET_V_DIM = 2 * RET_QK_DIM
RET_QK_WIDTH = RET_HEADS * RET_QK_DIM
RET_V_WIDTH = RET_HEADS * RET_V_DIM
RET_CHUNK = 128

MEM_HEADS = 4
MEM_WIDTH = D_MODEL
MEM_HEAD_DIM = MEM_WIDTH // MEM_HEADS

ROPE_BASE = 10000.0
NORM_EPS = 1e-6

IN_SPLITS = (POOL_WIDTH, POOL_WIDTH,
             RET_QK_WIDTH, RET_QK_WIDTH, RET_V_WIDTH, RET_V_WIDTH,
             MEM_WIDTH, MEM_WIDTH,
             D_MODEL, D_MODEL, D_MODEL)
IN_WIDTH = sum(IN_SPLITS)
IN_OFFSETS = tuple(int(o) for o in np.cumsum(IN_SPLITS)[:-1])

kernel_name = "hybrid_pool_retention_memory_gated_block"


def rmsnorm(x, g):
    xf = x.astype(jnp.float32)
    y = xf * lax.rsqrt(jnp.mean(xf * xf, axis=-1, keepdims=True) + NORM_EPS)
    return (y * g.astype(jnp.float32)).astype(x.dtype)


def causal_multiscale_pool(u, w_group, scale):
    B, S, W = u.shape
    uf = u.astype(jnp.float32)
    c = jnp.concatenate([jnp.zeros((B, 1, W), jnp.float32), jnp.cumsum(uf, axis=1)], axis=1)
    c = c.reshape(B, S + 1, POOL_GROUPS, POOL_GROUP_DIM)
    t = jnp.arange(S)
    pooled = []
    for gi, w in enumerate(POOL_WINDOWS):
        cg = c[:, :, gi]
        lo = cg[:, jnp.maximum(t + 1 - w, 0)]
        cnt = jnp.minimum(t + 1, w).astype(jnp.float32)
        pooled.append((cg[:, 1:] - lo) / cnt[None, :, None])
    pooled = jnp.stack(pooled, axis=2)
    mixed = pooled - uf.reshape(B, S, POOL_GROUPS, POOL_GROUP_DIM)
    y = jnp.einsum('bsgd,gde->bsge', mixed, w_group.astype(jnp.float32))
    y = y.reshape(B, S, W) * scale.astype(jnp.float32)
    return y.astype(u.dtype)


def rope(x, pos):
    half = x.shape[-1] // 2
    inv = ROPE_BASE ** (-jnp.arange(half, dtype=jnp.float32) / half)
    ang = pos[:, None] * inv[None, :]
    cos = jnp.cos(ang)[None, :, None, :]
    sin = jnp.sin(ang)[None, :, None, :]
    xf = x.astype(jnp.float32)
    x1, x2 = xf[..., :half], xf[..., half:]
    return jnp.concatenate([x1 * cos - x2 * sin, x2 * cos + x1 * sin], axis=-1)


def chunkwise_retention(q, k, v):
    B, S, H, dk = q.shape
    dv = v.shape[-1]
    C = RET_CHUNK
    N = S // C
    lg = jnp.log1p(-(2.0 ** (-5.0 - jnp.arange(H, dtype=jnp.float32))))
    idx = jnp.arange(C, dtype=jnp.float32)
    diff = idx[:, None] - idx[None, :]
    intra = jnp.where(diff >= 0, jnp.exp(jnp.maximum(diff, 0.0)[None] * lg[:, None, None]), 0.0)
    q_decay = jnp.exp((idx + 1.0)[None, :] * lg[:, None])
    k_decay = jnp.exp((C - 1.0 - idx)[None, :] * lg[:, None])
    chunk_decay = jnp.exp(C * lg)

    def to_chunks(a):
        d = a.shape[-1]
        return a.astype(jnp.float32).reshape(B, N, C, H, d).transpose(1, 0, 3, 2, 4)

    def step(state, xs):
        qc, kc, vc = xs
        scores = jnp.einsum('bhid,bhjd->bhij', qc, kc) * intra[None]
        inner = jnp.einsum('bhij,bhje->bhie', scores, vc)
        cross = jnp.einsum('bhid,bhde->bhie', qc * q_decay[None, :, :, None], state)
        new_state = state * chunk_decay[None, :, None, None] + jnp.einsum(
            'bhjd,bhje->bhde', kc * k_decay[None, :, :, None], vc)
        return new_state, inner + cross

    s0 = jnp.zeros((B, H, dk, dv), jnp.float32)
    _, o = lax.scan(step, s0, (to_chunks(q), to_chunks(k), to_chunks(v)))
    return o.transpose(1, 0, 3, 2, 4).reshape(B, S, H, dv)


def memory_cross_attention(qm, km, vm):
    scores = jnp.einsum('bshd,bmhd->bhsm', qm.astype(jnp.float32), km.astype(jnp.float32))
    p = jax.nn.softmax(scores * (MEM_HEAD_DIM ** -0.5), axis=-1)
    return jnp.einsum('bhsm,bmhd->bshd', p.astype(vm.dtype), vm)


def setup_inputs(seed: int = 0) -> dict:
    key = jax.random.key(seed)
    ks = jax.random.split(key, 16)
    f32 = jnp.float32

    def nrm(k, shape, fan_in):
        return jax.random.normal(k, shape, f32) * (fan_in ** -0.5)

    return {
        "x": jax.random.normal(ks[0], (BATCH, SEQ, D_MODEL), f32),
        "mem": jax.random.normal(ks[1], (BATCH, MEM_LEN, D_MODEL), f32),
        "norm_in": 1.0 + 0.02 * jax.random.normal(ks[2], (DEPTH, D_MODEL), f32),
        "norm_mem": 1.0 + 0.02 * jax.random.normal(ks[3], (DEPTH, D_MODEL), f32),
        "w_in": nrm(ks[4], (DEPTH, D_MODEL, IN_WIDTH), D_MODEL),
        "w_pool_group": nrm(ks[5], (DEPTH, POOL_GROUPS, POOL_GROUP_DIM, POOL_GROUP_DIM), POOL_GROUP_DIM),
        "pool_scale": 1.0 + 0.02 * jax.random.normal(ks[6], (DEPTH, POOL_WIDTH), f32),
        "w_mem_k": nrm(ks[7], (DEPTH, D_MODEL, MEM_WIDTH), D_MODEL),
        "w_mem_v": nrm(ks[8], (DEPTH, D_MODEL, MEM_WIDTH), D_MODEL),
        "w_proj_pool": nrm(ks[9], (DEPTH, POOL_WIDTH, D_MODEL), POOL_WIDTH),
        "w_proj_ret": nrm(ks[10], (DEPTH, RET_V_WIDTH, D_MODEL), RET_V_WIDTH),
        "w_proj_mem": nrm(ks[11], (DEPTH, MEM_WIDTH, D_MODEL), MEM_WIDTH),
        "w_out": nrm(ks[12], (DEPTH, D_MODEL, D_MODEL), D_MODEL),
        "norm_f": 1.0 + 0.02 * jax.random.normal(ks[13], (D_MODEL,), f32),
    }


def reference(x, mem, norm_in, norm_mem, w_in, w_pool_group, pool_scale, w_mem_k, w_mem_v,
              w_proj_pool, w_proj_ret, w_proj_mem, w_out, norm_f):
    B, S, _ = x.shape
    M = mem.shape[1]
    pos = jnp.arange(S, dtype=jnp.float32)
    for l in range(DEPTH):
        h = rmsnorm(x, norm_in[l])
        z = h @ w_in[l]
        (u_pool, g_pool, q, k, v, g_ret, q_mem, g_mem,
         a_pool, a_ret, a_mem) = jnp.split(z, IN_OFFSETS, axis=-1)

        pool_out = causal_multiscale_pool(u_pool, w_pool_group[l], pool_scale[l]) * jax.nn.silu(g_pool)
        branch_pool = pool_out @ w_proj_pool[l]

        qh = rope(q.reshape(B, S, RET_HEADS, RET_QK_DIM), pos)
        kh = rope(k.reshape(B, S, RET_HEADS, RET_QK_DIM), pos) * (RET_QK_DIM ** -0.5)
        vh = v.reshape(B, S, RET_HEADS, RET_V_DIM)
        o = chunkwise_retention(qh, kh, vh)
        o = o * lax.rsqrt(jnp.mean(o * o, axis=-1, keepdims=True) + NORM_EPS)
        ret_out = o.reshape(B, S, RET_V_WIDTH).astype(x.dtype) * jax.nn.silu(g_ret)
        branch_ret = ret_out @ w_proj_ret[l]

        memn = rmsnorm(mem, norm_mem[l])
        km = (memn @ w_mem_k[l]).reshape(B, M, MEM_HEADS, MEM_HEAD_DIM)
        vm = (memn @ w_mem_v[l]).reshape(B, M, MEM_HEADS, MEM_HEAD_DIM)
        mo = memory_cross_attention(q_mem.reshape(B, S, MEM_HEADS, MEM_HEAD_DIM), km, vm)
        mem_out = mo.reshape(B, S, MEM_WIDTH) * jax.nn.silu(g_mem)
        branch_mem = mem_out @ w_proj_mem[l]

        merged = (jax.nn.sigmoid(a_pool) * branch_pool
                  + jax.nn.sigmoid(a_ret) * branch_ret
                  + jax.nn.sigmoid(a_mem) * branch_mem)
        x = x + merged @ w_out[l]
    return rmsnorm(x, norm_f)
```

```cpp
#include <hip/hip_runtime.h>
#include <cstdio>
#include <cstdint>

#define LAS __attribute__((address_space(3)))
#define GAS __attribute__((address_space(1)))
typedef unsigned short bf16_t;
typedef short bf16x8 __attribute__((ext_vector_type(8)));
typedef float f32x4 __attribute__((ext_vector_type(4)));
typedef float f32x2 __attribute__((ext_vector_type(2)));
typedef unsigned u32x4 __attribute__((ext_vector_type(4)));
typedef unsigned u32x2 __attribute__((ext_vector_type(2)));

constexpr int SEQ = 8192, DM = 4096, MEML = 256, LDZ = 45056;
constexpr int NH = 16, DK = 256, DV = 512, CH = 256, NCH = SEQ / CH;
constexpr int ZO_U = 0, ZO_SGP = 4096, ZO_Q = 8192, ZO_K = 12288, ZO_SGR = 16384, ZO_QM = 24576, ZO_SGM = 28672, ZO_AP = 32768, ZO_AR = 36864, ZO_AM = 40960;
constexpr float NORM_EPS = 1e-6f;
constexpr int NWAVES = 8;

__device__ const float c_lg2g[16] = {
    -4.580368961e-02f, -2.272007650e-02f, -1.131531323e-02f, -5.646563141e-03f, -2.820519062e-03f, -1.409570255e-03f, -7.046129766e-04f, -3.522634716e-04f,
    -1.761209843e-04f, -8.805780458e-05f, -4.402823044e-05f, -2.201394726e-05f, -1.100693164e-05f, -5.503455325e-06f, -2.751725038e-06f, -1.375861863e-06f};
__device__ const float c_inv[128] = {
    1.000000000e+00f, 9.305720329e-01f, 8.659643531e-01f, 8.058421612e-01f, 7.498942018e-01f, 6.978305578e-01f, 6.493816376e-01f, 6.042963862e-01f, 5.623413324e-01f, 5.232990980e-01f, 4.869675338e-01f, 4.531583786e-01f, 4.216965139e-01f, 3.924189806e-01f, 3.651741147e-01f, 3.398208320e-01f,
    3.162277639e-01f, 2.942727208e-01f, 2.738419771e-01f, 2.548296750e-01f, 2.371373773e-01f, 2.206734121e-01f, 2.053525001e-01f, 1.910952926e-01f, 1.778279394e-01f, 1.654817164e-01f, 1.539926529e-01f, 1.433012635e-01f, 1.333521456e-01f, 1.240937784e-01f, 1.154781953e-01f, 1.074607819e-01f,
    1.000000015e-01f, 9.305720776e-02f, 8.659642935e-02f, 8.058422059e-02f, 7.498942316e-02f, 6.978306174e-02f, 6.493816525e-02f, 6.042964011e-02f, 5.623413250e-02f, 5.232991278e-02f, 4.869675264e-02f, 4.531583562e-02f, 4.216964915e-02f, 3.924189880e-02f, 3.651741147e-02f, 3.398208320e-02f,
    3.162277490e-02f, 2.942727134e-02f, 2.738419548e-02f, 2.548296750e-02f, 2.371373773e-02f, 2.206734009e-02f, 2.053525113e-02f, 1.910953037e-02f, 1.778279431e-02f, 1.654817164e-02f, 1.539926510e-02f, 1.433012541e-02f, 1.333521400e-02f, 1.240937784e-02f, 1.154781971e-02f, 1.074607857e-02f,
    9.999999776e-03f, 9.305720218e-03f, 8.659643121e-03f, 8.058422245e-03f, 7.498942316e-03f, 6.978305988e-03f, 6.493816152e-03f, 6.042963825e-03f, 5.623413250e-03f, 5.232991185e-03f, 4.869675264e-03f, 4.531583749e-03f, 4.216964822e-03f, 3.924189601e-03f, 3.651741194e-03f, 3.398208413e-03f,
    3.162277630e-03f, 2.942727180e-03f, 2.738419687e-03f, 2.548296703e-03f, 2.371373819e-03f, 2.206734149e-03f, 2.053525066e-03f, 1.910952968e-03f, 1.778279431e-03f, 1.654817141e-03f, 1.539926510e-03f, 1.433012541e-03f, 1.333521446e-03f, 1.240937738e-03f, 1.154782018e-03f, 1.074607833e-03f,
    1.000000047e-03f, 9.305720450e-04f, 8.659643354e-04f, 8.058421663e-04f, 7.498941850e-04f, 6.978305755e-04f, 6.493816036e-04f, 6.042963942e-04f, 5.623413017e-04f, 5.232990952e-04f, 4.869675322e-04f, 4.531583691e-04f, 4.216965172e-04f, 3.924189659e-04f, 3.651741135e-04f, 3.398208355e-04f,
    3.162277571e-04f, 2.942727297e-04f, 2.738419571e-04f, 2.548296761e-04f, 2.371373703e-04f, 2.206734061e-04f, 2.053525095e-04f, 1.910952997e-04f, 1.778279402e-04f, 1.654817170e-04f, 1.539926598e-04f, 1.433012512e-04f, 1.333521504e-04f, 1.240937709e-04f, 1.154782003e-04f, 1.074607862e-04f};

constexpr size_t MiB = 1u << 20;
constexpr size_t WS_CTL = 0, CTL_ZERO_BYTES = 4 * MiB;
constexpr int CW_BAR = 4096;
constexpr size_t CTL_RS = 1 * MiB;
constexpr size_t CTL_RSM = 1 * MiB + 512 * 1024;
constexpr size_t CTL_RSO = 1 * MiB + 768 * 1024;
constexpr size_t WS_WTA = CTL_ZERO_BYTES;
constexpr size_t WS_WTV = WS_WTA + (size_t)LDZ * DM * 2;
constexpr size_t WS_WG = WS_WTV + (size_t)8192 * DM * 2;
constexpr size_t WS_WK = WS_WG + (size_t)4 * 1024 * 1024 * 2;
constexpr size_t WS_WV = WS_WK + (size_t)DM * DM * 2;
constexpr size_t WS_WPP = WS_WV + (size_t)DM * DM * 2;
constexpr size_t WS_WPR = WS_WPP + (size_t)DM * DM * 2;
constexpr size_t WS_WPM = WS_WPR + (size_t)DM * 8192 * 2;
constexpr size_t WS_WO = WS_WPM + (size_t)DM * DM * 2;
constexpr size_t WS_H = WS_WO + (size_t)DM * DM * 2;
constexpr size_t WS_MEMN = WS_H + (size_t)SEQ * DM * 2;
constexpr size_t WS_ROPE = WS_MEMN + (size_t)MEML * DM * 2;
constexpr size_t WS_Z = WS_ROPE + (size_t)2 * SEQ * 128 * 4;
constexpr size_t WS_VS = WS_Z + (size_t)SEQ * LDZ * 2;
constexpr size_t WS_PQ = WS_VS + (size_t)NH * NCH * 512 * 512 * 2;
constexpr size_t WS_KDT = WS_PQ + (size_t)NH * SEQ * 512 * 2;
constexpr size_t WS_KVT = WS_KDT + (size_t)NH * NCH * 256 * 256 * 2;
constexpr size_t WS_O = WS_KVT + (size_t)NH * NCH * 512 * 256 * 2;
constexpr size_t WS_RETOUT = WS_O + (size_t)SEQ * 8192 * 2;
constexpr size_t WS_MIXED = WS_RETOUT + (size_t)SEQ * 8192 * 2;
constexpr size_t WS_POOLOUT = WS_MIXED + (size_t)SEQ * DM * 2;
constexpr size_t WS_MEMOUT = WS_POOLOUT + (size_t)SEQ * DM * 2;
constexpr size_t WS_KM = WS_MEMOUT + (size_t)SEQ * DM * 2;
constexpr size_t WS_VMT = WS_KM + (size_t)MEML * DM * 2;
constexpr size_t WS_PM = WS_VMT + (size_t)MEML * DM * 2;
constexpr size_t WS_MG = WS_PM + (size_t)4 * SEQ * 256 * 2;
constexpr size_t WS_MERGED = WS_MG + (size_t)SEQ * DM * 4;
constexpr size_t WS_END = WS_MERGED + (size_t)SEQ * DM * 2;

constexpr int RING_BYTES = 131072;
constexpr int LDSCTL_OFF = RING_BYTES, MISC_OFF = LDSCTL_OFF + 320;
constexpr int LDS_BYTES = 147456;

__device__ __forceinline__ unsigned cvt_pk_bf16(float lo, float hi) { unsigned r; asm volatile("v_cvt_pk_bf16_f32 %0, %1, %2" : "=v"(r) : "v"(lo), "v"(hi)); return r; }
__device__ __forceinline__ float bf_lo(unsigned w) { return __uint_as_float(w << 16); }
__device__ __forceinline__ float bf_hi(unsigned w) { return __uint_as_float(w & 0xffff0000u); }
__device__ __forceinline__ f32x4 bf4_lo(u32x4 g) { return (f32x4){bf_lo(g.x), bf_hi(g.x), bf_lo(g.y), bf_hi(g.y)}; }
__device__ __forceinline__ f32x4 bf4_hi(u32x4 g) { return (f32x4){bf_lo(g.z), bf_hi(g.z), bf_lo(g.w), bf_hi(g.w)}; }
__device__ __forceinline__ u32x4 pack8(f32x4 a, f32x4 b) { u32x4 w; w.x = cvt_pk_bf16(a[0], a[1]); w.y = cvt_pk_bf16(a[2], a[3]); w.z = cvt_pk_bf16(b[0], b[1]); w.w = cvt_pk_bf16(b[2], b[3]); return w; }
__device__ __forceinline__ float sigm(float x) { return __builtin_amdgcn_rcpf(1.0f + __builtin_amdgcn_exp2f(-1.44269504f * x)); }
__device__ __forceinline__ void atomic_addf(float* p, float v) { (void)__hip_atomic_fetch_add(p, v, __ATOMIC_RELAXED, __HIP_MEMORY_SCOPE_AGENT); }
__device__ __forceinline__ int lane_id() { int l = (int)__builtin_amdgcn_mbcnt_hi(~0u, __builtin_amdgcn_mbcnt_lo(~0u, 0u)); asm volatile("" : "+v"(l)); return l; }
__device__ __forceinline__ float wave_sum(float v) {
#pragma unroll
    for (int o = 1; o < 64; o <<= 1) v += __shfl_xor(v, o);
    return v;
}

namespace pg8 {
constexpr int BM = 256, BK = 64, HALF = 128, HTB = HALF * BK * 2, STAGE_BYTES = 8 * HTB, NXCD = 8, WGM = 8;
__host__ __device__ __forceinline__ int lds_byte(int r, int c) { const int st = (r >> 4) * 2 + (c >> 5), rr = r & 15, cc = c & 31, ob = rr * 64 + cc * 2; return st * 1024 + (ob ^ (((ob >> 9) & 1) << 5)); }
__host__ __device__ __forceinline__ void stage_rc(int b, int& R, int& C) { const int st = b / 1024, sb = b % 1024, swz = sb ^ (((sb >> 9) & 1) << 5); R = (st >> 1) * 16 + swz / 64; C = (st & 1) * 32 + (swz % 64) / 2; }
__host__ __device__ __forceinline__ int perm32(int rho) { const int n = rho >> 4, i = rho & 15; return 8 * (i >> 2) + 4 * n + (i & 3); }

struct Unit { int pm, pn, b; };

struct StaticOrder {
    int nM, nN, nwg, G, c;
    __device__ void init(int nM_, int nN_, int G_, int c_) { nM = nM_; nN = nN_; nwg = nM * nN; G = G_; c = c_; }
    __device__ bool next(int i, Unit& u) const {
        const long L = (long)i * G + c; if (L >= nwg) return false;
        int wgid = (int)L; { const int q = nwg / NXCD, r = nwg % NXCD, xcd = wgid % NXCD, off = wgid / NXCD; wgid = (xcd < r ? xcd * (q + 1) : r * (q + 1) + (xcd - r) * q) + off; }
        const int nig = WGM * nN, gid = wgid / nig, fm = gid * WGM, gsz = (nM - fm) < WGM ? (nM - fm) : WGM;
        u.pm = fm + ((wgid % nig) % gsz); u.pn = (wgid % nig) / gsz; u.b = 0; return true;
    }
    __device__ __forceinline__ void a_ready(const Unit&) const {}
    __device__ __forceinline__ void done(const Unit&) const {}
};
struct BatchOrder {
    int nM, nN, total, G, c;
    __device__ void init(int nb, int nM_, int nN_, int G_, int c_) { nM = nM_; nN = nN_; total = nb * nM * nN; G = G_; c = c_; }
    __device__ bool next(int i, Unit& u) const {
        const int L = i * G + c; if (L >= total) return false;
        u.pn = L % nN; const int t = L / nN; u.pm = t % nM; u.b = t / nM; return true;
    }
    __device__ __forceinline__ void a_ready(const Unit&) const {}
    __device__ __forceinline__ void done(const Unit&) const {}
};
template <int LDA, int LDB, int NT, int A_PM, int A_PN, int A_B, int B_PM, int B_PN, int B_B>
struct Prob {
    const bf16_t* A; const bf16_t* B;
    static constexpr int lda = LDA, ldb = LDB, nt = NT;
    __device__ __forceinline__ const char* a_base(const Unit& u) const { return (const char*)(A + (u.pm * A_PM + u.pn * A_PN + u.b * A_B)); }
    __device__ __forceinline__ const char* b_base(const Unit& u) const { return (const char*)(B + (u.pm * B_PM + u.pn * B_PN + u.b * B_B)); }
};

template <class ProbT, class Epi, class Sched, bool ALIGN_EPI = true>
__device__ __forceinline__ void gemm_phase(LAS unsigned char* lds, const int wid, const ProbT P, const Sched& S, const Epi& E) {
    const int lane = lane_id(), tid = wid * 64 + lane, wr = wid >> 2, wc = wid & 3, fr = lane & 15, fq = lane >> 4;
    constexpr int nt = ProbT::nt;
    unsigned voffA[2], voffB[2];
#pragma unroll
    for (int i = 0; i < 2; ++i) { int R, C; stage_rc(tid * 16 + i * 8192, R, C); const int Rb = Epi::PERM ? ((R & ~31) + perm32(R & 31)) : R;
        voffA[i] = (unsigned)(R * ProbT::lda + C) * 2u; voffB[i] = (unsigned)(Rb * ProbT::ldb + C) * 2u; }
    const size_t kstep = (size_t)(BK * 2);
    constexpr size_t hstepA = (size_t)HALF * ProbT::lda * 2, hstepB = (size_t)HALF * ProbT::ldb * 2;
    const unsigned ldsw = (unsigned)wid * 1024u;
    const int aoff = lds_byte(wr * 64 + fr, fq * 8), boff = lds_byte(wc * 32 + fr, fq * 8);
#define PG8_SA(b, h) (((b) * 2 + (h)) * HTB)
#define PG8_SB(b, h) ((4 + (b) * 2 + (h)) * HTB)
#define PG8_STAGE(bufoff, gbase, voff) do { _Pragma("unroll") for (int _i = 0; _i < 2; ++_i) \
        __builtin_amdgcn_global_load_lds((const unsigned*)((const char*)(gbase) + (voff)[_i]), (LAS unsigned*)(lds + (bufoff) + ldsw + _i * 8192), 16, 0, 0); } while (0)
#define PG8_LDA(dst, b, h) do { _Pragma("unroll") for (int m = 0; m < 4; ++m) _Pragma("unroll") for (int k = 0; k < 2; ++k) dst[m][k] = *(const LAS bf16x8*)(lds + PG8_SA(b, h) + aoff + m * 2048 + k * 1024); } while (0)
#define PG8_LDB(dst, b, h) do { _Pragma("unroll") for (int n = 0; n < 2; ++n) _Pragma("unroll") for (int k = 0; k < 2; ++k) dst[n][k] = *(const LAS bf16x8*)(lds + PG8_SB(b, h) + boff + n * 2048 + k * 1024); } while (0)
#define PG8_MMA(ai, bj, At, Bt) do { __builtin_amdgcn_s_setprio(1); _Pragma("unroll") for (int m = 0; m < 4; ++m) _Pragma("unroll") for (int n = 0; n < 2; ++n) _Pragma("unroll") for (int k = 0; k < 2; ++k) \
        acc[ai][bj][m][n] = __builtin_amdgcn_mfma_f32_16x16x32_bf16(Bt[n][k], At[m][k], acc[ai][bj][m][n], 0, 0, 0); __builtin_amdgcn_s_setprio(0); } while (0)
#define PG8_WAIT_V(n) asm volatile("s_waitcnt vmcnt(" #n ")" ::: "memory")
#define PG8_WAIT_L(n) asm volatile("s_waitcnt lgkmcnt(" #n ")" ::: "memory")
#define PG8_BAR __builtin_amdgcn_s_barrier()
#define PG8_SCHED __builtin_amdgcn_sched_barrier(0)
    Unit cur, nxt; int ui = 0;
    if (!S.next(0, cur)) return;
    f32x4 acc[2][2][4][2];
#pragma unroll
    for (int a = 0; a < 2; ++a)
#pragma unroll
        for (int b = 0; b < 2; ++b)
#pragma unroll
            for (int m = 0; m < 4; ++m)
#pragma unroll
                for (int n = 0; n < 2; ++n) acc[a][b][m][n] = (f32x4){0.f, 0.f, 0.f, 0.f};
    bf16x8 At[4][2], B0[2][2], B1[2][2];
    const char* cA = P.a_base(cur); const char* cB = P.b_base(cur);
    S.a_ready(cur);
    PG8_STAGE(PG8_SB(0, 0), cB, voffB); PG8_STAGE(PG8_SB(0, 1), cB + hstepB, voffB); PG8_STAGE(PG8_SA(0, 0), cA, voffA); PG8_STAGE(PG8_SA(0, 1), cA + hstepA, voffA);
    if (wr == 1) PG8_BAR;
    PG8_WAIT_V(2); PG8_BAR;
    PG8_STAGE(PG8_SB(1, 0), cB + kstep, voffB); PG8_STAGE(PG8_SA(1, 0), cA + kstep, voffA); PG8_STAGE(PG8_SB(1, 1), cB + hstepB + kstep, voffB);
    PG8_WAIT_V(6); PG8_BAR;
    for (;;) {
        const bool has_next = S.next(ui + 1, nxt);
        const char* nA = has_next ? P.a_base(nxt) : cA; const char* nB = has_next ? P.b_base(nxt) : cB;
        for (int t = 0; t < nt; t += 2) {
            const bool last = (t == nt - 2);
            const char* a1 = cA + (size_t)(t + 1) * kstep;
            const char* a2 = last ? nA : cA + (size_t)(t + 2) * kstep; const char* b2 = last ? nB : cB + (size_t)(t + 2) * kstep;
            const char* a3 = a2 + kstep; const char* b3 = b2 + kstep;
            if (last && has_next) S.a_ready(nxt);
            PG8_LDB(B0, 0, 0); PG8_LDB(B1, 0, 1); PG8_SCHED; PG8_LDA(At, 0, 0); PG8_STAGE(PG8_SA(1, 1), a1 + hstepA, voffA);
            PG8_WAIT_V(8); PG8_WAIT_L(0); PG8_BAR; PG8_MMA(0, 0, At, B0); PG8_MMA(0, 1, At, B1); PG8_BAR; PG8_SCHED;
            PG8_LDA(At, 0, 1); PG8_STAGE(PG8_SB(0, 0), b2, voffB); PG8_STAGE(PG8_SB(0, 1), b2 + hstepB, voffB); PG8_STAGE(PG8_SA(0, 0), a2, voffA);
            PG8_WAIT_V(8); PG8_WAIT_L(0); PG8_BAR; PG8_MMA(1, 0, At, B0); PG8_MMA(1, 1, At, B1); PG8_BAR; PG8_SCHED;
            PG8_LDB(B0, 1, 0); PG8_LDB(B1, 1, 1); PG8_SCHED; PG8_LDA(At, 1, 0); PG8_STAGE(PG8_SA(0, 1), a2 + hstepA, voffA);
            PG8_WAIT_V(8); PG8_WAIT_L(0); PG8_BAR; PG8_MMA(0, 0, At, B0); PG8_MMA(0, 1, At, B1); PG8_BAR; PG8_SCHED;
            PG8_LDA(At, 1, 1); PG8_STAGE(PG8_SB(1, 0), b3, voffB); PG8_STAGE(PG8_SB(1, 1), b3 + hstepB, voffB); PG8_STAGE(PG8_SA(1, 0), a3, voffA);
            PG8_WAIT_V(8); PG8_WAIT_L(0); PG8_BAR; PG8_MMA(1, 0, At, B0); PG8_MMA(1, 1, At, B1); PG8_BAR; PG8_SCHED;
        }
        if constexpr (ALIGN_EPI) { if (wr == 0) PG8_BAR; }
        E(acc, cur, wr, wc); S.done(cur);
        if (!has_next) break;
#pragma unroll
        for (int a = 0; a < 2; ++a)
#pragma unroll
            for (int b = 0; b < 2; ++b)
#pragma unroll
                for (int m = 0; m < 4; ++m)
#pragma unroll
                    for (int n = 0; n < 2; ++n) acc[a][b][m][n] = (f32x4){0.f, 0.f, 0.f, 0.f};
        cur = nxt; cA = nA; cB = nB; ++ui;
        if constexpr (ALIGN_EPI) { if (wr == 1) PG8_BAR; }
    }
    PG8_WAIT_V(0);
    if constexpr (!ALIGN_EPI) { if (wr == 0) PG8_BAR; }
    PG8_BAR;
#undef PG8_SA
#undef PG8_SB
#undef PG8_STAGE
#undef PG8_LDA
#undef PG8_LDB
#undef PG8_MMA
#undef PG8_WAIT_V
#undef PG8_WAIT_L
#undef PG8_BAR
#undef PG8_SCHED
}

typedef const f32x4 (&AccRef)[2][2][4][2];
#define ROWG(ai, m) ({ int _r = (ai) * 128 + (m) * 16; asm volatile("" : "+v"(_r)); _r; })

struct EpiPlain {
    static constexpr bool PERM = true;
    bf16_t* O; int ldc, sb, spm, spn;
    __device__ __forceinline__ void operator()(AccRef acc, const Unit& u, int wr, int wc) const {
        const int lane_ = lane_id(), fr = lane_ & 15, fq = lane_ >> 4;
        bf16_t* base = O + (u.b * sb + u.pm * spm + u.pn * spn) + (wr * 64 + fr) * ldc + wc * 32 + fq * 8;
#pragma unroll
        for (int ai = 0; ai < 2; ++ai)
#pragma unroll
            for (int m = 0; m < 4; ++m)
#pragma unroll
                for (int bj = 0; bj < 2; ++bj) *(u32x4*)(base + (size_t)(ai * 128 + m * 16) * ldc + bj * 128) = pack8(acc[ai][bj][m][0], acc[ai][bj][m][1]);
    }
};

struct EpiMain {
    static constexpr bool PERM = true;
    bf16_t* Z; bf16_t* PQ; bf16_t* KdT; const float* ropec; const float* ropes;
    __device__ __forceinline__ void operator()(AccRef acc, const Unit& u, int wr, int wc) const {
        const int lane_ = lane_id(), fr = lane_ & 15, fq = lane_ >> 4;
        const int pn = u.pn, lr0 = wr * 64 + fr, lc = wc * 32 + fq * 8;
        bf16_t* zb = Z + (size_t)(u.pm * 256 + lr0) * LDZ + pn * 256 + lc;
        if (pn >= 32 && pn < 64) {
            const bool isk = pn >= 48; const int head = (pn - 32) & 15; const float lg = c_lg2g[head];
#pragma unroll
            for (int ai = 0; ai < 2; ++ai)
#pragma unroll
                for (int m = 0; m < 4; ++m) {
                    const int rg = ROWG(ai, m), il = lr0 + rg, row = u.pm * 256 + il;
                    const f32x4 c0 = *(const f32x4*)(ropec + (size_t)row * 128 + lc), c1 = *(const f32x4*)(ropec + (size_t)row * 128 + lc + 4);
                    const f32x4 s0 = *(const f32x4*)(ropes + (size_t)row * 128 + lc), s1 = *(const f32x4*)(ropes + (size_t)row * 128 + lc + 4);
                    const f32x4 x10 = acc[ai][0][m][0], x11 = acc[ai][0][m][1], x20 = acc[ai][1][m][0], x21 = acc[ai][1][m][1];
                    const f32x4 y10 = x10 * c0 - x20 * s0, y11 = x11 * c1 - x21 * s1, y20 = x20 * c0 + x10 * s0, y21 = x21 * c1 + x11 * s1;
                    bf16_t* zr = zb + (size_t)rg * LDZ;
                    *(u32x4*)zr = pack8(y10, y11); *(u32x4*)(zr + 128) = pack8(y20, y21);
                    if (!isk) {
                        const float dq = __builtin_amdgcn_exp2f((float)(il + 1) * lg);
                        bf16_t* pq = PQ + ((size_t)head * SEQ + row) * 512 + 256 + lc;
                        *(u32x4*)pq = pack8(y10 * dq, y11 * dq); *(u32x4*)(pq + 128) = pack8(y20 * dq, y21 * dq);
                    } else {
                        const float dk = __builtin_amdgcn_exp2f((float)(255 - il) * lg);
                        bf16_t* kt = KdT + ((size_t)(head * NCH + u.pm) * 256 + lc) * 256 + il;
                        const u32x4 w1 = pack8(y10 * dk, y11 * dk), w2 = pack8(y20 * dk, y21 * dk);
                        kt[0 * 256] = (bf16_t)(w1.x & 0xffffu); kt[1 * 256] = (bf16_t)(w1.x >> 16); kt[2 * 256] = (bf16_t)(w1.y & 0xffffu); kt[3 * 256] = (bf16_t)(w1.y >> 16);
                        kt[4 * 256] = (bf16_t)(w1.z & 0xffffu); kt[5 * 256] = (bf16_t)(w1.z >> 16); kt[6 * 256] = (bf16_t)(w1.w & 0xffffu); kt[7 * 256] = (bf16_t)(w1.w >> 16);
                        bf16_t* kt2 = kt + 128 * 256;
                        kt2[0 * 256] = (bf16_t)(w2.x & 0xffffu); kt2[1 * 256] = (bf16_t)(w2.x >> 16); kt2[2 * 256] = (bf16_t)(w2.y & 0xffffu); kt2[3 * 256] = (bf16_t)(w2.y >> 16);
                        kt2[4 * 256] = (bf16_t)(w2.z & 0xffffu); kt2[5 * 256] = (bf16_t)(w2.z >> 16); kt2[6 * 256] = (bf16_t)(w2.w & 0xffffu); kt2[7 * 256] = (bf16_t)(w2.w >> 16);
                    }
                    asm volatile("" ::: "memory");
                }
        } else {
            const int act = (pn < 16) ? 0 : (pn < 96) ? 1 : (pn < 112) ? 0 : (pn < 128) ? 1 : 2;
#pragma unroll
            for (int ai = 0; ai < 2; ++ai)
#pragma unroll
                for (int m = 0; m < 4; ++m) { const int rg = ROWG(ai, m);
#pragma unroll
                    for (int bj = 0; bj < 2; ++bj) {
                        f32x4 v0 = acc[ai][bj][m][0], v1 = acc[ai][bj][m][1];
#pragma unroll
                        for (int e = 0; e < 4; ++e) { const float s0 = sigm(v0[e]), s1 = sigm(v1[e]);
                            v0[e] = act == 0 ? v0[e] : (act == 1 ? v0[e] * s0 : s0); v1[e] = act == 0 ? v1[e] : (act == 1 ? v1[e] * s1 : s1); }
                        *(u32x4*)(zb + (size_t)rg * LDZ + bj * 128) = pack8(v0, v1);
                    }
                    asm volatile("" ::: "memory"); }
        }
    }
};

struct EpiVt {
    static constexpr bool PERM = true;
    bf16_t* VS;
    __device__ __forceinline__ void operator()(AccRef acc, const Unit& u, int wr, int wc) const {
        const int lane_ = lane_id(), fr = lane_ & 15, fq = lane_ >> 4;
        bf16_t* base = VS + ((size_t)((u.pm >> 1) * NCH + u.pn) * 512 + (u.pm & 1) * 256 + wr * 64 + fr) * 512 + wc * 32 + fq * 8;
#pragma unroll
        for (int ai = 0; ai < 2; ++ai)
#pragma unroll
            for (int m = 0; m < 4; ++m)
#pragma unroll
                for (int bj = 0; bj < 2; ++bj) *(u32x4*)(base + (size_t)(ai * 128 + m * 16) * 512 + bj * 128) = pack8(acc[ai][bj][m][0], acc[ai][bj][m][1]);
    }
};

struct EpiScores {
    static constexpr bool PERM = true;
    bf16_t* PQ;
    __device__ __forceinline__ void operator()(AccRef acc, const Unit& u, int wr, int wc) const {
        const int lane_ = lane_id(), fr = lane_ & 15, fq = lane_ >> 4;
        const float lg = c_lg2g[u.b]; const int lr0 = wr * 64 + fr, lc = wc * 32 + fq * 8;
        bf16_t* base = PQ + ((size_t)u.b * SEQ + u.pm * 256 + lr0) * 512 + lc;
        float gp[8];
#pragma unroll
        for (int e = 0; e < 8; ++e) gp[e] = __builtin_amdgcn_exp2f((float)(7 - e) * lg);
#pragma unroll
        for (int ai = 0; ai < 2; ++ai)
#pragma unroll
            for (int m = 0; m < 4; ++m) { const int rg = ROWG(ai, m);
#pragma unroll
                for (int bj = 0; bj < 2; ++bj) {
                    const int dd = (lr0 + rg) - (lc + bj * 128);
                    const float g0 = __builtin_amdgcn_exp2f((float)(dd - 7) * lg);
                    f32x4 v0 = acc[ai][bj][m][0], v1 = acc[ai][bj][m][1];
#pragma unroll
                    for (int e = 0; e < 4; ++e) { v0[e] = (dd - e) >= 0 ? v0[e] * (g0 * gp[e]) : 0.f; v1[e] = (dd - 4 - e) >= 0 ? v1[e] * (g0 * gp[4 + e]) : 0.f; }
                    *(u32x4*)(base + (size_t)rg * 512 + bj * 128) = pack8(v0, v1);
                }
                asm volatile("" ::: "memory");
            }
    }
};

struct EpiRetOut {
    static constexpr bool PERM = true;
    bf16_t* O; float* RS;
    __device__ __forceinline__ void operator()(AccRef acc, const Unit& u, int wr, int wc) const {
        const int lane_ = lane_id(), fr = lane_ & 15, fq = lane_ >> 4;
        const int row0 = u.pm * 256 + wr * 64 + fr;
        bf16_t* base = O + (size_t)row0 * 8192 + u.b * 512 + u.pn * 256 + wc * 32 + fq * 8;
#pragma unroll
        for (int ai = 0; ai < 2; ++ai)
#pragma unroll
            for (int m = 0; m < 4; ++m) { const int rg = ROWG(ai, m);
                float s = 0.f;
#pragma unroll
                for (int bj = 0; bj < 2; ++bj) { const f32x4 v0 = acc[ai][bj][m][0], v1 = acc[ai][bj][m][1];
                    s += (v0[0] * v0[0] + v0[1] * v0[1]) + (v0[2] * v0[2] + v0[3] * v0[3]) + (v1[0] * v1[0] + v1[1] * v1[1]) + (v1[2] * v1[2] + v1[3] * v1[3]);
                    *(u32x4*)(base + (size_t)rg * 8192 + bj * 128) = pack8(v0, v1); }
                s += __shfl_xor(s, 16); s += __shfl_xor(s, 32);
                if (fq == 0) atomic_addf(RS + (size_t)u.b * SEQ + row0 + rg, s);
                asm volatile("" ::: "memory");
            }
    }
};

struct EpiMemS {
    static constexpr bool PERM = true;
    bf16_t* Pm; float* RSm;
    __device__ __forceinline__ void operator()(AccRef acc, const Unit& u, int wr, int wc) const {
        const int lane_ = lane_id(), fr = lane_ & 15, fq = lane_ >> 4;
        const int row0 = u.pm * 256 + wr * 64 + fr;
        bf16_t* base = Pm + ((size_t)u.b * SEQ + row0) * 256 + wc * 32 + fq * 8;
#pragma unroll
        for (int ai = 0; ai < 2; ++ai)
#pragma unroll
            for (int m = 0; m < 4; ++m) { const int rg = ROWG(ai, m);
                float s = 0.f;
#pragma unroll
                for (int bj = 0; bj < 2; ++bj) { f32x4 v0 = acc[ai][bj][m][0], v1 = acc[ai][bj][m][1];
#pragma unroll
                    for (int e = 0; e < 4; ++e) { v0[e] = __builtin_amdgcn_exp2f(fminf(v0[e], 80.f) * 1.44269504f); v1[e] = __builtin_amdgcn_exp2f(fminf(v1[e], 80.f) * 1.44269504f); }
                    const u32x4 w = pack8(v0, v1);
                    s += (bf_lo(w.x) + bf_hi(w.x)) + (bf_lo(w.y) + bf_hi(w.y)) + (bf_lo(w.z) + bf_hi(w.z)) + (bf_lo(w.w) + bf_hi(w.w));
                    *(u32x4*)(base + (size_t)rg * 256 + bj * 128) = w; }
                s += __shfl_xor(s, 16); s += __shfl_xor(s, 32);
                if (fq == 0) atomic_addf(RSm + (size_t)u.b * SEQ + row0 + rg, s);
                asm volatile("" ::: "memory");
            }
    }
};

struct EpiMemPV {
    static constexpr bool PERM = true;
    const float* RSm; const bf16_t* Zg; bf16_t* Out;
    __device__ __forceinline__ void operator()(AccRef acc, const Unit& u, int wr, int wc) const {
        const int lane_ = lane_id(), fr = lane_ & 15, fq = lane_ >> 4;
        const int row0 = u.pm * 256 + wr * 64 + fr, col0 = u.b * 1024 + u.pn * 256 + wc * 32 + fq * 8;
#pragma unroll
        for (int ai = 0; ai < 2; ++ai)
#pragma unroll
            for (int m = 0; m < 4; ++m) { const int row = row0 + ROWG(ai, m);
                const float rinv = 1.0f / RSm[(size_t)u.b * SEQ + row];
#pragma unroll
                for (int bj = 0; bj < 2; ++bj) { const u32x4 g = *(const u32x4*)(Zg + (size_t)row * LDZ + col0 + bj * 128);
                    *(u32x4*)(Out + (size_t)row * DM + col0 + bj * 128) = pack8(acc[ai][bj][m][0] * rinv * bf4_lo(g), acc[ai][bj][m][1] * rinv * bf4_hi(g)); }
                asm volatile("" ::: "memory"); }
    }
};

struct EpiPool {
    static constexpr bool PERM = true;
    const float* scale; const bf16_t* Zg; bf16_t* Out;
    __device__ __forceinline__ void operator()(AccRef acc, const Unit& u, int wr, int wc) const {
        const int lane_ = lane_id(), fr = lane_ & 15, fq = lane_ >> 4;
        const int row0 = u.pm * 256 + wr * 64 + fr, col0 = u.b * 1024 + u.pn * 256 + wc * 32 + fq * 8;
        f32x4 sc[2][2];
#pragma unroll
        for (int bj = 0; bj < 2; ++bj) { sc[bj][0] = *(const f32x4*)(scale + col0 + bj * 128); sc[bj][1] = *(const f32x4*)(scale + col0 + bj * 128 + 4); }
#pragma unroll
        for (int ai = 0; ai < 2; ++ai)
#pragma unroll
            for (int m = 0; m < 4; ++m) { const int row = row0 + ROWG(ai, m);
#pragma unroll
                for (int bj = 0; bj < 2; ++bj) { const u32x4 g = *(const u32x4*)(Zg + (size_t)row * LDZ + col0 + bj * 128);
                    *(u32x4*)(Out + (size_t)row * DM + col0 + bj * 128) = pack8(acc[ai][bj][m][0] * sc[bj][0] * bf4_lo(g), acc[ai][bj][m][1] * sc[bj][1] * bf4_hi(g)); }
                asm volatile("" ::: "memory"); }
    }
};

template <int STAGE> struct EpiProj {
    static constexpr bool PERM = true;
    const bf16_t* Zg; float* Mg; bf16_t* Merged;
    __device__ __forceinline__ void operator()(AccRef acc, const Unit& u, int wr, int wc) const {
        const int lane_ = lane_id(), fr = lane_ & 15, fq = lane_ >> 4;
        const int row0 = u.pm * 256 + wr * 64 + fr, col0 = u.pn * 256 + wc * 32 + fq * 8;
#pragma unroll
        for (int ai = 0; ai < 2; ++ai)
#pragma unroll
            for (int m = 0; m < 4; ++m) { const int row = row0 + ROWG(ai, m);
#pragma unroll
                for (int bj = 0; bj < 2; ++bj) { const u32x4 g = *(const u32x4*)(Zg + (size_t)row * LDZ + col0 + bj * 128);
                    f32x4 v0 = acc[ai][bj][m][0] * bf4_lo(g), v1 = acc[ai][bj][m][1] * bf4_hi(g);
                    float* mp = Mg + (size_t)row * DM + col0 + bj * 128;
                    if (STAGE > 0) { v0 += *(const f32x4*)mp; v1 += *(const f32x4*)(mp + 4); }
                    if (STAGE < 2) { *(f32x4*)mp = v0; *(f32x4*)(mp + 4) = v1; }
                    else *(u32x4*)(Merged + (size_t)row * DM + col0 + bj * 128) = pack8(v0, v1); }
                asm volatile("" ::: "memory"); }
    }
};

struct EpiOutProj {
    static constexpr bool PERM = false;
    const float* x; float* out; float* RSo;
    __device__ __forceinline__ void operator()(AccRef acc, const Unit& u, int wr, int wc) const {
        const int lane_ = lane_id(), fr = lane_ & 15, fq = lane_ >> 4;
        const int row0 = u.pm * 256 + wr * 64 + fr, col0 = u.pn * 256 + wc * 32 + fq * 4;
#pragma unroll
        for (int ai = 0; ai < 2; ++ai)
#pragma unroll
            for (int m = 0; m < 4; ++m) { const int row = row0 + ROWG(ai, m); float s = 0.f;
#pragma unroll
                for (int bj = 0; bj < 2; ++bj)
#pragma unroll
                    for (int n = 0; n < 2; ++n) { const size_t off = (size_t)row * DM + col0 + bj * 128 + n * 16;
                        const f32x4 v = *(const f32x4*)(x + off) + acc[ai][bj][m][n]; *(f32x4*)(out + off) = v;
                        s += (v[0] * v[0] + v[1] * v[1]) + (v[2] * v[2] + v[3] * v[3]); }
                s += __shfl_xor(s, 16); s += __shfl_xor(s, 32);
                if (fq == 0) atomic_addf(RSo + row, s);
                asm volatile("" ::: "memory"); }
    }
};
}

#define XB_TMO      128
#define XB_XCNT(j)  (256  + 64 * (j))
#define XB_XSUB(j)  (1280 + 64 * (j))
#define XB_XGEN(j)  (2304 + 64 * (j))
#define XB_TOP      3328
#define XB_TOPGEN   3392
#define XCD_BAR_WORDS 3456
#define XB_SPIN_CAP (1u << 18)
__device__ __forceinline__ unsigned xb_ld(unsigned* p)              { return __hip_atomic_load(p, __ATOMIC_RELAXED, __HIP_MEMORY_SCOPE_AGENT); }
__device__ __forceinline__ unsigned xb_add(unsigned* p, unsigned v) { return __hip_atomic_fetch_add(p, v, __ATOMIC_RELAXED, __HIP_MEMORY_SCOPE_AGENT); }
__device__ __forceinline__ unsigned xb_xcc_id() { return (unsigned)__builtin_amdgcn_s_getreg((3 << 11) | 20) & 0xFu; }
#define XB_SPIN(cond, bar) do { unsigned _sp = 0; while (cond) { __builtin_amdgcn_s_sleep(1); \
    if ((++_sp & 255u) == 0u) { if (xb_ld(&(bar)[XB_TMO])) break; if (_sp > XB_SPIN_CAP) { atomicAdd(&(bar)[XB_TMO], 1u); break; } } } } while (0)
struct XcdBarrier { unsigned* bar; unsigned x; volatile LAS unsigned* st; };
__device__ __forceinline__ XcdBarrier xcd_barrier_post(unsigned* bar, volatile LAS unsigned* st, bool leader) {
    XcdBarrier b; b.bar = bar; b.x = xb_xcc_id(); b.st = st;
    if (leader) (void)xb_add(&bar[XB_XCNT(b.x)], 1u);
    return b;
}
__device__ __forceinline__ void xcd_barrier_complete(unsigned* bar, unsigned x, unsigned& nloc, unsigned& nx) {
    const unsigned G = gridDim.x * gridDim.y * gridDim.z;
    unsigned sum, cnt, mine, sp = 0u;
    for (;;) {
        sum = 0u; cnt = 0u; mine = 0u;
#pragma unroll
        for (unsigned j = 0; j < 16; ++j) { const unsigned c = xb_ld(&bar[XB_XCNT(j)]); sum += c; cnt += (c > 0u) ? 1u : 0u; mine = (j == x) ? c : mine; }
        if (sum == G) break;
        __builtin_amdgcn_s_sleep(1);
        if ((++sp & 255u) == 0u) { if (xb_ld(&bar[XB_TMO])) break; if (sp > XB_SPIN_CAP) { atomicAdd(&bar[XB_TMO], 1u); break; } }
    }
    nloc = mine > 0u ? mine : 1u; nx = cnt > 0u ? cnt : 1u;
}
__device__ __forceinline__ void xcd_barrier(const XcdBarrier& b, bool leader) {
    asm volatile("s_waitcnt vmcnt(0)" ::: "memory");
    __syncthreads();
    if (leader) {
        unsigned* bar = b.bar;
        __builtin_amdgcn_s_waitcnt(0);
        unsigned nloc = b.st[0], nx = b.st[1];
        if (nloc == 0u) { xcd_barrier_complete(bar, b.x, nloc, nx); b.st[0] = nloc; b.st[1] = nx; }
        const unsigned old = xb_add(&bar[XB_XSUB(b.x)], 1u);
        const unsigned gen = old / nloc;
        if (old + 1u == (gen + 1u) * nloc) {
            __builtin_amdgcn_fence(__ATOMIC_RELEASE, "agent");
            asm volatile("s_waitcnt vmcnt(0)" ::: "memory");
            const unsigned og = xb_add(&bar[XB_TOP], 1u);
            const unsigned tg = og / nx;
            if (og + 1u == (tg + 1u) * nx) xb_add(&bar[XB_TOPGEN], 1u);
            else XB_SPIN(xb_ld(&bar[XB_TOPGEN]) == tg, bar);
            __builtin_amdgcn_fence(__ATOMIC_ACQUIRE, "agent");
            xb_add(&bar[XB_XGEN(b.x)], 1u);
            asm volatile("s_waitcnt vmcnt(0)" ::: "memory");
        } else {
            XB_SPIN(xb_ld(&bar[XB_XGEN(b.x)]) == gen, bar);
            __builtin_amdgcn_fence(__ATOMIC_ACQUIRE, "agent");
            asm volatile("s_waitcnt vmcnt(0)" ::: "memory");
        }
    }
    __syncthreads();
}

#define LDS_WAIT() asm volatile("s_waitcnt lgkmcnt(0)" ::: "memory")
__device__ __forceinline__ void transpose_item(const float* W, int ldw, int col0, int k0, bf16_t* WT, int ldt, int row0, float scale, LAS float* scr, int lane) {
#pragma unroll 8
    for (int i = 0; i < 32; ++i) { const int kk = 2 * i + (lane >> 5); scr[kk * 33 + (lane & 31)] = W[(size_t)(k0 + kk) * ldw + col0 + (lane & 31)]; }
    LDS_WAIT(); asm volatile("" ::: "memory");
    const int c = lane & 7;
#pragma unroll
    for (int j = 0; j < 4; ++j) { const int n = (lane >> 3) + 8 * j; const LAS float* s = scr + (8 * c) * 33 + n;
        u32x4 o; o.x = cvt_pk_bf16(s[0 * 33] * scale, s[1 * 33] * scale); o.y = cvt_pk_bf16(s[2 * 33] * scale, s[3 * 33] * scale); o.z = cvt_pk_bf16(s[4 * 33] * scale, s[5 * 33] * scale); o.w = cvt_pk_bf16(s[6 * 33] * scale, s[7 * 33] * scale);
        *(u32x4*)(WT + (size_t)(row0 + n) * ldt + k0 + 8 * c) = o; }
    LDS_WAIT(); asm volatile("" ::: "memory");
}
__device__ __forceinline__ void transpose_job(const float* W, int K, int ldw, int coff, int ncols, bf16_t* WT, int roff, float scale, LAS float* scr, int lane, int gw, int ngw) {
    const int nblk = ncols / 32, items = (K / 64) * nblk;
    for (int it = gw; it < items; it += ngw) { const int kb = it / nblk, nb = it % nblk;
        transpose_item(W, ldw, coff + 32 * nb, 64 * kb, WT, K, roff + 32 * nb, scale, scr, lane); }
}
__device__ __forceinline__ void rms_row_to_bf16(const float* xrow, const float* g, bf16_t* orow, int lane) {
    const f32x4* xr = (const f32x4*)xrow + lane; const f32x4* gr = (const f32x4*)g + lane;
    f32x4 v[16]; float s = 0.f;
#pragma unroll
    for (int j = 0; j < 16; ++j) { v[j] = xr[64 * j]; s += (v[j][0] * v[j][0] + v[j][1] * v[j][1]) + (v[j][2] * v[j][2] + v[j][3] * v[j][3]); }
    const float rstd = 1.0f / sqrtf(wave_sum(s) * (1.0f / DM) + NORM_EPS);
    u32x2* o8 = (u32x2*)orow + lane;
#pragma unroll
    for (int j = 0; j < 16; ++j) { const f32x4 gg = gr[64 * j]; u32x2 w; w.x = cvt_pk_bf16(v[j][0] * rstd * gg[0], v[j][1] * rstd * gg[1]); w.y = cvt_pk_bf16(v[j][2] * rstd * gg[2], v[j][3] * rstd * gg[3]); o8[64 * j] = w; }
}

struct Args { const float* in[14]; float* out; unsigned char* ws; };
#define WSP(type, off) ((type*)(ws + (off)))
__global__ void __launch_bounds__(NWAVES * 64, 2) fwd(Args args) {
    extern __shared__ __attribute__((aligned(16))) unsigned char lds_raw[];
    LAS unsigned char* lds = (LAS unsigned char*)lds_raw;
    const int G = gridDim.x, bx = blockIdx.x;
    unsigned char* const ws = args.ws;
    unsigned* const ctl = (unsigned*)(ws + WS_CTL);
    using pg8::Prob; using pg8::gemm_phase;

    const int wave = __builtin_amdgcn_readfirstlane((int)threadIdx.x >> 6);
    for (int u = threadIdx.x; u < (LDS_BYTES - LDSCTL_OFF) / 4; u += NWAVES * 64) ((LAS unsigned*)(lds + LDSCTL_OFF))[u] = 0u;
    __syncthreads();
    (void)xcd_barrier_post(ctl + CW_BAR, (volatile LAS unsigned*)(lds + MISC_OFF) + 8, wave == 0 && lane_id() == 0);
#define GRID_BAR() do { XcdBarrier _b; _b.bar = (unsigned*)(args.ws + WS_CTL) + CW_BAR; _b.x = xb_xcc_id(); _b.st = (volatile LAS unsigned*)(lds + MISC_OFF) + 8; xcd_barrier(_b, wave == 0 && lane_id() == 0); } while (0)
#define TIDS() const int lane = lane_id(), tid = wave * 64 + lane; \
    const int gw = bx * NWAVES + wave, ngw = G * NWAVES; const size_t gt = (size_t)bx * (NWAVES * 64) + tid, ngt = (size_t)G * (NWAVES * 64); (void)lane; (void)gw; (void)ngw; (void)gt; (void)ngt

    {
        TIDS();
        const float* w_in = args.in[4];
        LAS float* scr = (LAS float*)(lds + wave * 16384);
        bf16_t* WtA = WSP(bf16_t, WS_WTA);
        transpose_job(w_in, DM, 53248, 0, 12288, WtA, 0, 1.0f, scr, lane, gw, ngw);
        transpose_job(w_in, DM, 53248, 12288, 4096, WtA, 12288, 0.0625f, scr, lane, gw, ngw);
        transpose_job(w_in, DM, 53248, 16384, 8192, WSP(bf16_t, WS_WTV), 0, 1.0f, scr, lane, gw, ngw);
        transpose_job(w_in, DM, 53248, 24576, 8192, WtA, 16384, 1.0f, scr, lane, gw, ngw);
        transpose_job(w_in, DM, 53248, 32768, 4096, WtA, 24576, 0.03125f, scr, lane, gw, ngw);
        transpose_job(w_in, DM, 53248, 36864, 16384, WtA, 28672, 1.0f, scr, lane, gw, ngw);
#pragma unroll 1
        for (int g = 0; g < 4; ++g) transpose_job(args.in[5] + (size_t)g * 1024 * 1024, 1024, 1024, 0, 1024, WSP(bf16_t, WS_WG) + (size_t)g * 1024 * 1024, 0, 1.0f, scr, lane, gw, ngw);
        transpose_job(args.in[7], DM, DM, 0, DM, WSP(bf16_t, WS_WK), 0, 1.0f, scr, lane, gw, ngw);
        transpose_job(args.in[8], DM, DM, 0, DM, WSP(bf16_t, WS_WV), 0, 1.0f, scr, lane, gw, ngw);
        transpose_job(args.in[9], DM, DM, 0, DM, WSP(bf16_t, WS_WPP), 0, 1.0f, scr, lane, gw, ngw);
        transpose_job(args.in[10], 8192, DM, 0, DM, WSP(bf16_t, WS_WPR), 0, 1.0f, scr, lane, gw, ngw);
        transpose_job(args.in[11], DM, DM, 0, DM, WSP(bf16_t, WS_WPM), 0, 1.0f, scr, lane, gw, ngw);
        transpose_job(args.in[12], DM, DM, 0, DM, WSP(bf16_t, WS_WO), 0, 1.0f, scr, lane, gw, ngw);
        for (int m = gw; m < SEQ + MEML; m += ngw) {
            if (m < SEQ) rms_row_to_bf16(args.in[0] + (size_t)m * DM, args.in[2], WSP(bf16_t, WS_H) + (size_t)m * DM, lane);
            else rms_row_to_bf16(args.in[1] + (size_t)(m - SEQ) * DM, args.in[3], WSP(bf16_t, WS_MEMN) + (size_t)(m - SEQ) * DM, lane);
        }
        float* ropec = WSP(float, WS_ROPE); float* ropes = ropec + (size_t)SEQ * 128;
        for (size_t i = gt; i < (size_t)SEQ * 128; i += ngt) {
            const int pos = (int)(i >> 7), fi = (int)(i & 127);
            const float ang = (float)pos * c_inv[fi];
            const double rev = (double)ang * 0.15915494309189533577; const float fr_ = (float)(rev - __builtin_rint(rev));
            ropec[i] = __builtin_amdgcn_cosf(fr_); ropes[i] = __builtin_amdgcn_sinf(fr_);
        }
    }
    GRID_BAR();

    {
        { Prob<DM, DM, DM / 64, 0, 0, 0, 0, 256 * DM, 0> p{WSP(bf16_t, WS_MEMN), WSP(bf16_t, WS_WK)}; pg8::BatchOrder S; S.init(1, 1, 16, G, bx);
          pg8::EpiPlain E{WSP(bf16_t, WS_KM), DM, 0, 0, 256}; gemm_phase(lds, wave, p, S, E); }
        { Prob<DM, DM, DM / 64, 256 * DM, 0, 0, 0, 0, 0> p{WSP(bf16_t, WS_WV), WSP(bf16_t, WS_MEMN)}; pg8::BatchOrder S; S.init(1, 16, 1, G, (bx + G - 16) % G);
          pg8::EpiPlain E{WSP(bf16_t, WS_VMT), 256, 0, 256 * 256, 0}; gemm_phase(lds, wave, p, S, E); }
        { Prob<DM, DM, DM / 64, 256 * DM, 0, 0, 0, 256 * DM, 0> p{WSP(bf16_t, WS_H), WSP(bf16_t, WS_WTA)}; pg8::StaticOrder S; S.init(SEQ / 256, LDZ / 256, G, bx);
          pg8::EpiMain E{WSP(bf16_t, WS_Z), WSP(bf16_t, WS_PQ), WSP(bf16_t, WS_KDT), WSP(float, WS_ROPE), WSP(float, WS_ROPE) + (size_t)SEQ * 128}; gemm_phase(lds, wave, p, S, E); }
        { Prob<DM, DM, DM / 64, 256 * DM, 0, 0, 0, 256 * DM, 0> p{WSP(bf16_t, WS_WTV), WSP(bf16_t, WS_H)}; pg8::StaticOrder S; S.init(8192 / 256, SEQ / 256, G, bx);
          pg8::EpiVt E{WSP(bf16_t, WS_VS)}; gemm_phase(lds, wave, p, S, E); }
    }
    GRID_BAR();

    {
        {
            TIDS();
            const bf16_t* Z = WSP(bf16_t, WS_Z); bf16_t* Mixed = WSP(bf16_t, WS_MIXED);
            for (size_t i = gt; i < (size_t)SEQ * 512; i += ngt) {
                const int c8 = (int)(i & 511), t = (int)(i >> 9), w = 2 << (c8 >> 7);
                const int lo = (t - w + 1) > 0 ? (t - w + 1) : 0;
                const bf16_t* up = Z + ZO_U + c8 * 8;
                f32x4 s0 = (f32x4){0.f, 0.f, 0.f, 0.f}, s1 = s0;
                for (int s = lo; s < t; ++s) { const u32x4 v = *(const u32x4*)(up + (size_t)s * LDZ); s0 += bf4_lo(v); s1 += bf4_hi(v); }
                const u32x4 vt = *(const u32x4*)(up + (size_t)t * LDZ); const f32x4 u0 = bf4_lo(vt), u1 = bf4_hi(vt);
                const float rc = 1.0f / (float)(t - lo + 1);
                *(u32x4*)(Mixed + (size_t)t * DM + c8 * 8) = pack8((s0 + u0) * rc - u0, (s1 + u1) * rc - u1);
            }
        }
        { Prob<512, 256, 4, 512 * 512, 256 * 512, NCH * 512 * 512, 256 * 256, 0, NCH * 256 * 256> p{WSP(bf16_t, WS_VS), WSP(bf16_t, WS_KDT)}; pg8::BatchOrder S; S.init(NH, NCH, 2, G, bx);
          pg8::EpiPlain E{WSP(bf16_t, WS_KVT), 256, NCH * 512 * 256, 512 * 256, 256 * 256}; gemm_phase(lds, wave, p, S, E); }
        { Prob<LDZ, LDZ, 4, 256 * LDZ, 0, 256, 256 * LDZ, 0, 256> p{WSP(bf16_t, WS_Z) + ZO_Q, WSP(bf16_t, WS_Z) + ZO_K}; pg8::BatchOrder S; S.init(NH, NCH, 1, G, bx);
          pg8::EpiScores E{WSP(bf16_t, WS_PQ)}; gemm_phase(lds, wave, p, S, E); }
        { Prob<LDZ, DM, 16, 256 * LDZ, 0, 1024, 0, 0, 1024> p{WSP(bf16_t, WS_Z) + ZO_QM, WSP(bf16_t, WS_KM)}; pg8::BatchOrder S; S.init(4, SEQ / 256, 1, G, bx);
          pg8::EpiMemS E{WSP(bf16_t, WS_PM), WSP(float, CTL_RSM)}; gemm_phase(lds, wave, p, S, E); }
    }
    GRID_BAR();

    {
        {
            TIDS();
            for (size_t i = gt; i < (size_t)NH * 512 * 32; i += ngt) {
                const int d8 = (int)(i & 31), e = (int)((i >> 5) & 511), h = (int)(i >> 14);
                const float gc = __builtin_amdgcn_exp2f(256.0f * c_lg2g[h]);
                f32x4 s0 = (f32x4){0.f, 0.f, 0.f, 0.f}, s1 = s0;
                const bf16_t* kv = WSP(bf16_t, WS_KVT) + ((size_t)(h * NCH) * 512 + e) * 256 + d8 * 8;
                bf16_t* st = WSP(bf16_t, WS_VS) + ((size_t)(h * NCH) * 512 + e) * 512 + 256 + d8 * 8;
#pragma unroll 4
                for (int n = 0; n < NCH; ++n) {
                    *(u32x4*)(st + (size_t)n * 512 * 512) = pack8(s0, s1);
                    const u32x4 v = *(const u32x4*)(kv + (size_t)n * 512 * 256);
                    s0 = s0 * gc + bf4_lo(v); s1 = s1 * gc + bf4_hi(v);
                }
            }
        }
        { Prob<DM, 1024, 16, 256 * DM, 0, 1024, 0, 256 * 1024, 1024 * 1024> p{WSP(bf16_t, WS_MIXED), WSP(bf16_t, WS_WG)}; pg8::BatchOrder S; S.init(4, SEQ / 256, 4, G, bx);
          pg8::EpiPool E{args.in[6], WSP(bf16_t, WS_Z) + ZO_SGP, WSP(bf16_t, WS_POOLOUT)}; gemm_phase(lds, wave, p, S, E); }
        { Prob<256, 256, 4, 256 * 256, 0, SEQ * 256, 0, 256 * 256, 1024 * 256> p{WSP(bf16_t, WS_PM), WSP(bf16_t, WS_VMT)}; pg8::BatchOrder S; S.init(4, SEQ / 256, 4, G, bx);
          pg8::EpiMemPV E{WSP(float, CTL_RSM), WSP(bf16_t, WS_Z) + ZO_SGM, WSP(bf16_t, WS_MEMOUT)}; gemm_phase(lds, wave, p, S, E); }
    }
    GRID_BAR();

    {
        Prob<512, 512, 8, 256 * 512, 0, SEQ * 512, 512 * 512, 256 * 512, NCH * 512 * 512> p{WSP(bf16_t, WS_PQ), WSP(bf16_t, WS_VS)}; pg8::BatchOrder S; S.init(NH, NCH, 2, G, bx);
        pg8::EpiRetOut E{WSP(bf16_t, WS_O), WSP(float, CTL_RS)}; gemm_phase(lds, wave, p, S, E);
    }
    GRID_BAR();

    {
        TIDS();
        const float* RS = WSP(float, CTL_RS); const bf16_t* Ob = WSP(bf16_t, WS_O); const bf16_t* Z = WSP(bf16_t, WS_Z); bf16_t* RetOut = WSP(bf16_t, WS_RETOUT);
        for (size_t i = gt; i < (size_t)SEQ * 1024; i += ngt) {
            const int c8 = (int)(i & 1023), t = (int)(i >> 10), h = c8 >> 6;
            const float rstd = 1.0f / sqrtf(RS[(size_t)h * SEQ + t] * (1.0f / DV) + NORM_EPS);
            const u32x4 o = *(const u32x4*)(Ob + (size_t)t * 8192 + c8 * 8), g = *(const u32x4*)(Z + (size_t)t * LDZ + ZO_SGR + c8 * 8);
            *(u32x4*)(RetOut + (size_t)t * 8192 + c8 * 8) = pack8(bf4_lo(o) * rstd * bf4_lo(g), bf4_hi(o) * rstd * bf4_hi(g));
        }
    }
    GRID_BAR();

    {
        { Prob<DM, DM, DM / 64, 256 * DM, 0, 0, 0, 256 * DM, 0> p{WSP(bf16_t, WS_POOLOUT), WSP(bf16_t, WS_WPP)}; pg8::StaticOrder S; S.init(SEQ / 256, DM / 256, G, bx);
          pg8::EpiProj<0> E{WSP(bf16_t, WS_Z) + ZO_AP, WSP(float, WS_MG), WSP(bf16_t, WS_MERGED)}; gemm_phase(lds, wave, p, S, E); }
        { Prob<8192, 8192, 8192 / 64, 256 * 8192, 0, 0, 0, 256 * 8192, 0> p{WSP(bf16_t, WS_RETOUT), WSP(bf16_t, WS_WPR)}; pg8::StaticOrder S; S.init(SEQ / 256, DM / 256, G, bx);
          pg8::EpiProj<1> E{WSP(bf16_t, WS_Z) + ZO_AR, WSP(float, WS_MG), WSP(bf16_t, WS_MERGED)}; gemm_phase(lds, wave, p, S, E); }
        { Prob<DM, DM, DM / 64, 256 * DM, 0, 0, 0, 256 * DM, 0> p{WSP(bf16_t, WS_MEMOUT), WSP(bf16_t, WS_WPM)}; pg8::StaticOrder S; S.init(SEQ / 256, DM / 256, G, bx);
          pg8::EpiProj<2> E{WSP(bf16_t, WS_Z) + ZO_AM, WSP(float, WS_MG), WSP(bf16_t, WS_MERGED)}; gemm_phase(lds, wave, p, S, E); }
    }
    GRID_BAR();

    {
        Prob<DM, DM, DM / 64, 256 * DM, 0, 0, 0, 256 * DM, 0> p{WSP(bf16_t, WS_MERGED), WSP(bf16_t, WS_WO)}; pg8::StaticOrder S; S.init(SEQ / 256, DM / 256, G, bx);
        pg8::EpiOutProj E{args.in[0], args.out, WSP(float, CTL_RSO)}; gemm_phase(lds, wave, p, S, E);
    }
    GRID_BAR();

    {
        TIDS();
        const bool bad = xb_ld(ctl + CW_BAR + XB_TMO) != 0u;
        const float* RSo = WSP(float, CTL_RSO); const float* norm_f = args.in[13]; float* out = args.out;
        for (size_t i = gt; i < (size_t)SEQ * 1024; i += ngt) {
            const int c4 = (int)(i & 1023), t = (int)(i >> 10);
            const float rstd = 1.0f / sqrtf(RSo[t] * (1.0f / DM) + NORM_EPS);
            f32x4 v = *(const f32x4*)(out + (size_t)t * DM + c4 * 4) * rstd * *(const f32x4*)(norm_f + c4 * 4);
            if (bad) v = (f32x4){__builtin_nanf(""), __builtin_nanf(""), __builtin_nanf(""), __builtin_nanf("")};
            *(f32x4*)(out + (size_t)t * DM + c4 * 4) = v;
        }
    }
}

extern "C" void kernel_launch(void* const* d_in, const int* in_sizes, int n_in, void* d_out, int out_size, void* d_ws, size_t ws_size, hipStream_t stream) {
    static int grid = 0;
    if (grid == 0) {
        if (n_in != 14 || out_size != SEQ * DM || ws_size < WS_END) { fprintf(stderr, "kernel_launch: unexpected shapes (n_in %d, out %d, ws %zu < %zu); nothing launched\n", n_in, out_size, ws_size, (size_t)WS_END); grid = -1; return; }
        int dev = 0, cus = 0, per_cu = 0;
        if (hipGetDevice(&dev) != hipSuccess || hipDeviceGetAttribute(&cus, hipDeviceAttributeMultiprocessorCount, dev) != hipSuccess) { grid = -1; return; }
        if (hipFuncSetAttribute((const void*)fwd, hipFuncAttributeMaxDynamicSharedMemorySize, LDS_BYTES) != hipSuccess) { fprintf(stderr, "kernel_launch: hipFuncSetAttribute failed\n"); grid = -1; return; }
        if (hipOccupancyMaxActiveBlocksPerMultiprocessor(&per_cu, (const void*)fwd, NWAVES * 64, LDS_BYTES) != hipSuccess || per_cu < 1) fprintf(stderr, "kernel_launch: occupancy query reports %d\n", per_cu);
        (void)hipGetLastError();
        grid = cus;
    }
    if (grid < 0) return;
    (void)in_sizes;
    if (hipMemsetAsync((char*)d_ws + WS_CTL, 0, CTL_ZERO_BYTES, stream) != hipSuccess) return;
    Args a{};
    for (int i = 0; i < 14; ++i) a.in[i] = (const float*)d_in[i];
    a.out = (float*)d_out; a.ws = (unsigned char*)d_ws;
    hipLaunchKernelGGL(fwd, dim3(grid), dim3(NWAVES * 64), LDS_BYTES, stream, a);
}
```

```cpp
#include <hip/hip_runtime.h>
#include <cstdio>
#include <cstdint>
#ifndef BIG_ALIGN
#define BIG_ALIGN true
#endif
#ifndef BIG_SP2
#define BIG_SP2 true
#endif

#define LAS __attribute__((address_space(3)))
#define GAS __attribute__((address_space(1)))
typedef unsigned short bf16_t;
typedef short bf16x8 __attribute__((ext_vector_type(8)));
typedef float f32x4 __attribute__((ext_vector_type(4)));
typedef float f32x2 __attribute__((ext_vector_type(2)));
typedef unsigned u32x4 __attribute__((ext_vector_type(4)));
typedef unsigned u32x2 __attribute__((ext_vector_type(2)));

constexpr int SEQ = 8192, DM = 4096, MEML = 256, LDZ = 45056;
constexpr int NH = 16, DK = 256, DV = 512, CH = 256, NCH = SEQ / CH;
constexpr int ZO_U = 0, ZO_SGP = 4096, ZO_Q = 8192, ZO_K = 12288, ZO_SGR = 16384, ZO_QM = 24576, ZO_SGM = 28672, ZO_AP = 32768, ZO_AR = 36864, ZO_AM = 40960;
constexpr float NORM_EPS = 1e-6f;
constexpr int NWAVES = 8;

__device__ const float c_lg2g[16] = {
    -4.580368961e-02f, -2.272007650e-02f, -1.131531323e-02f, -5.646563141e-03f, -2.820519062e-03f, -1.409570255e-03f, -7.046129766e-04f, -3.522634716e-04f,
    -1.761209843e-04f, -8.805780458e-05f, -4.402823044e-05f, -2.201394726e-05f, -1.100693164e-05f, -5.503455325e-06f, -2.751725038e-06f, -1.375861863e-06f};
__device__ const float c_inv[128] = {
    1.000000000e+00f, 9.305720329e-01f, 8.659643531e-01f, 8.058421612e-01f, 7.498942018e-01f, 6.978305578e-01f, 6.493816376e-01f, 6.042963862e-01f, 5.623413324e-01f, 5.232990980e-01f, 4.869675338e-01f, 4.531583786e-01f, 4.216965139e-01f, 3.924189806e-01f, 3.651741147e-01f, 3.398208320e-01f,
    3.162277639e-01f, 2.942727208e-01f, 2.738419771e-01f, 2.548296750e-01f, 2.371373773e-01f, 2.206734121e-01f, 2.053525001e-01f, 1.910952926e-01f, 1.778279394e-01f, 1.654817164e-01f, 1.539926529e-01f, 1.433012635e-01f, 1.333521456e-01f, 1.240937784e-01f, 1.154781953e-01f, 1.074607819e-01f,
    1.000000015e-01f, 9.305720776e-02f, 8.659642935e-02f, 8.058422059e-02f, 7.498942316e-02f, 6.978306174e-02f, 6.493816525e-02f, 6.042964011e-02f, 5.623413250e-02f, 5.232991278e-02f, 4.869675264e-02f, 4.531583562e-02f, 4.216964915e-02f, 3.924189880e-02f, 3.651741147e-02f, 3.398208320e-02f,
    3.162277490e-02f, 2.942727134e-02f, 2.738419548e-02f, 2.548296750e-02f, 2.371373773e-02f, 2.206734009e-02f, 2.053525113e-02f, 1.910953037e-02f, 1.778279431e-02f, 1.654817164e-02f, 1.539926510e-02f, 1.433012541e-02f, 1.333521400e-02f, 1.240937784e-02f, 1.154781971e-02f, 1.074607857e-02f,
    9.999999776e-03f, 9.305720218e-03f, 8.659643121e-03f, 8.058422245e-03f, 7.498942316e-03f, 6.978305988e-03f, 6.493816152e-03f, 6.042963825e-03f, 5.623413250e-03f, 5.232991185e-03f, 4.869675264e-03f, 4.531583749e-03f, 4.216964822e-03f, 3.924189601e-03f, 3.651741194e-03f, 3.398208413e-03f,
    3.162277630e-03f, 2.942727180e-03f, 2.738419687e-03f, 2.548296703e-03f, 2.371373819e-03f, 2.206734149e-03f, 2.053525066e-03f, 1.910952968e-03f, 1.778279431e-03f, 1.654817141e-03f, 1.539926510e-03f, 1.433012541e-03f, 1.333521446e-03f, 1.240937738e-03f, 1.154782018e-03f, 1.074607833e-03f,
    1.000000047e-03f, 9.305720450e-04f, 8.659643354e-04f, 8.058421663e-04f, 7.498941850e-04f, 6.978305755e-04f, 6.493816036e-04f, 6.042963942e-04f, 5.623413017e-04f, 5.232990952e-04f, 4.869675322e-04f, 4.531583691e-04f, 4.216965172e-04f, 3.924189659e-04f, 3.651741135e-04f, 3.398208355e-04f,
    3.162277571e-04f, 2.942727297e-04f, 2.738419571e-04f, 2.548296761e-04f, 2.371373703e-04f, 2.206734061e-04f, 2.053525095e-04f, 1.910952997e-04f, 1.778279402e-04f, 1.654817170e-04f, 1.539926598e-04f, 1.433012512e-04f, 1.333521504e-04f, 1.240937709e-04f, 1.154782003e-04f, 1.074607862e-04f};

constexpr size_t MiB = 1u << 20;
constexpr size_t WS_CTL = 0, CTL_ZERO_BYTES = 4 * MiB;
constexpr int CW_BAR = 4096;
constexpr size_t CTL_RS = 1 * MiB;
constexpr size_t CTL_RSM = 1 * MiB + 512 * 1024;
constexpr size_t CTL_RSO = 1 * MiB + 768 * 1024;
constexpr size_t WS_WTA = CTL_ZERO_BYTES;
constexpr size_t WS_WTV = WS_WTA + (size_t)LDZ * DM * 2;
constexpr size_t WS_WG = WS_WTV + (size_t)8192 * DM * 2;
constexpr size_t WS_WK = WS_WG + (size_t)4 * 1024 * 1024 * 2;
constexpr size_t WS_WV = WS_WK + (size_t)DM * DM * 2;
constexpr size_t WS_WPP = WS_WV + (size_t)DM * DM * 2;
constexpr size_t WS_WPR = WS_WPP + (size_t)DM * DM * 2;
constexpr size_t WS_WPM = WS_WPR + (size_t)DM * 8192 * 2;
constexpr size_t WS_WO = WS_WPM + (size_t)DM * DM * 2;
constexpr size_t WS_H = WS_WO + (size_t)DM * DM * 2;
constexpr size_t WS_MEMN = WS_H + (size_t)SEQ * DM * 2;
constexpr size_t WS_ROPE = WS_MEMN + (size_t)MEML * DM * 2;
constexpr size_t WS_Z = WS_ROPE + (size_t)2 * SEQ * 128 * 4;
constexpr size_t WS_VS = WS_Z + (size_t)SEQ * LDZ * 2;
constexpr size_t WS_PQ = WS_VS + (size_t)NH * NCH * 512 * 512 * 2;
constexpr size_t WS_KDT = WS_PQ + (size_t)NH * SEQ * 512 * 2;
constexpr size_t WS_KVT = WS_KDT + (size_t)NH * NCH * 256 * 256 * 2;
constexpr size_t WS_O = WS_KVT + (size_t)NH * NCH * 512 * 256 * 2;
constexpr size_t WS_RETOUT = WS_O + (size_t)SEQ * 8192 * 2;
constexpr size_t WS_MIXED = WS_RETOUT + (size_t)SEQ * 8192 * 2;
constexpr size_t WS_POOLOUT = WS_MIXED + (size_t)SEQ * DM * 2;
constexpr size_t WS_MEMOUT = WS_POOLOUT + (size_t)SEQ * DM * 2;
constexpr size_t WS_KM = WS_MEMOUT + (size_t)SEQ * DM * 2;
constexpr size_t WS_VMT = WS_KM + (size_t)MEML * DM * 2;
constexpr size_t WS_PM = WS_VMT + (size_t)MEML * DM * 2;
constexpr size_t WS_MG = WS_PM + (size_t)4 * SEQ * 256 * 2;
constexpr size_t WS_MERGED = WS_MG + (size_t)SEQ * DM * 4;
constexpr size_t WS_KMP = WS_MERGED + (size_t)SEQ * DM * 2;
constexpr size_t WS_VMTP = WS_KMP + (size_t)8 * MEML * DM * 4;
constexpr size_t WS_END = WS_VMTP + (size_t)8 * MEML * DM * 4;

constexpr int RING_BYTES = 131072;
constexpr int TR_TILE_BYTES = 64 * 65 * 4;
constexpr int LDSCTL_OFF = 8 * TR_TILE_BYTES, MISC_OFF = LDSCTL_OFF + 320;
static_assert(LDSCTL_OFF >= RING_BYTES, "LDS map");
constexpr int LDS_BYTES = 147456;

__device__ __forceinline__ unsigned cvt_pk_bf16(float lo, float hi) { unsigned r; asm volatile("v_cvt_pk_bf16_f32 %0, %1, %2" : "=v"(r) : "v"(lo), "v"(hi)); return r; }
__device__ __forceinline__ float bf_lo(unsigned w) { return __uint_as_float(w << 16); }
__device__ __forceinline__ float bf_hi(unsigned w) { return __uint_as_float(w & 0xffff0000u); }
__device__ __forceinline__ f32x4 bf4_lo(u32x4 g) { return (f32x4){bf_lo(g.x), bf_hi(g.x), bf_lo(g.y), bf_hi(g.y)}; }
__device__ __forceinline__ f32x4 bf4_hi(u32x4 g) { return (f32x4){bf_lo(g.z), bf_hi(g.z), bf_lo(g.w), bf_hi(g.w)}; }
__device__ __forceinline__ u32x4 pack8(f32x4 a, f32x4 b) { u32x4 w; w.x = cvt_pk_bf16(a[0], a[1]); w.y = cvt_pk_bf16(a[2], a[3]); w.z = cvt_pk_bf16(b[0], b[1]); w.w = cvt_pk_bf16(b[2], b[3]); return w; }
__device__ __forceinline__ float sigm(float x) { return __builtin_amdgcn_rcpf(1.0f + __builtin_amdgcn_exp2f(-1.44269504f * x)); }
__device__ __forceinline__ void atomic_addf(float* p, float v) { (void)__hip_atomic_fetch_add(p, v, __ATOMIC_RELAXED, __HIP_MEMORY_SCOPE_AGENT); }
__device__ __forceinline__ int lane_id() { int l = (int)__builtin_amdgcn_mbcnt_hi(~0u, __builtin_amdgcn_mbcnt_lo(~0u, 0u)); asm volatile("" : "+v"(l)); return l; }
__device__ __forceinline__ float shx(float v, int lane, int mask) { return __int_as_float(__builtin_amdgcn_ds_bpermute((lane ^ mask) << 2, __float_as_int(v))); }
__device__ __forceinline__ float wave_sum(float v, int lane) {
#pragma unroll
    for (int o = 1; o < 64; o <<= 1) v += shx(v, lane, o);
    return v;
}

namespace pg8 {
constexpr int BM = 256, BK = 64, HALF = 128, HTB = HALF * BK * 2, STAGE_BYTES = 8 * HTB, NXCD = 8, WGM = 8;
__host__ __device__ __forceinline__ int lds_byte(int r, int c) { const int st = (r >> 4) * 2 + (c >> 5), rr = r & 15, cc = c & 31, ob = rr * 64 + cc * 2; return st * 1024 + (ob ^ (((ob >> 9) & 1) << 5)); }
__host__ __device__ __forceinline__ void stage_rc(int b, int& R, int& C) { const int st = b / 1024, sb = b % 1024, swz = sb ^ (((sb >> 9) & 1) << 5); R = (st >> 1) * 16 + swz / 64; C = (st & 1) * 32 + (swz % 64) / 2; }
__host__ __device__ __forceinline__ int perm32(int rho) { const int n = rho >> 4, i = rho & 15; return 8 * (i >> 2) + 4 * n + (i & 3); }

struct Unit { int pm, pn, b; };

struct StaticOrder {
    int nM, nN, nwg, G, c;
    __device__ void init(int nM_, int nN_, int G_, int c_) { nM = nM_; nN = nN_; nwg = nM * nN; G = G_; c = c_; }
    __device__ bool next(int i, Unit& u) const {
        const long L = (long)i * G + c; if (L >= nwg) return false;
        int wgid = (int)L; { const int q = nwg / NXCD, r = nwg % NXCD, xcd = wgid % NXCD, off = wgid / NXCD; wgid = (xcd < r ? xcd * (q + 1) : r * (q + 1) + (xcd - r) * q) + off; }
        const int nig = WGM * nN, gid = wgid / nig, fm = gid * WGM, gsz = (nM - fm) < WGM ? (nM - fm) : WGM;
        u.pm = fm + ((wgid % nig) % gsz); u.pn = (wgid % nig) / gsz; u.b = 0; return true;
    }
    __device__ __forceinline__ void a_ready(const Unit&) const {}
    __device__ __forceinline__ void done(const Unit&) const {}
};
struct BatchOrder {
    int nM, nN, total, G, c;
    __device__ void init(int nb, int nM_, int nN_, int G_, int c_) { nM = nM_; nN = nN_; total = nb * nM * nN; G = G_; c = c_; }
    __device__ bool next(int i, Unit& u) const {
        const int L = i * G + c; if (L >= total) return false;
        u.pn = L % nN; const int t = L / nN; u.pm = t % nM; u.b = t / nM; return true;
    }
    __device__ __forceinline__ void a_ready(const Unit&) const {}
    __device__ __forceinline__ void done(const Unit&) const {}
};
template <int LDA, int LDB, int NT, int A_PM, int A_PN, int A_B, int B_PM, int B_PN, int B_B>
struct Prob {
    const bf16_t* A; const bf16_t* B;
    static constexpr int lda = LDA, ldb = LDB, nt = NT;
    __device__ __forceinline__ const char* a_base(const Unit& u) const { return (const char*)(A + (u.pm * A_PM + u.pn * A_PN + u.b * A_B)); }
    __device__ __forceinline__ const char* b_base(const Unit& u) const { return (const char*)(B + (u.pm * B_PM + u.pn * B_PN + u.b * B_B)); }
};

template <bool ALIGN_EPI = true, bool SP2 = true, class ProbT, class Epi, class Sched>
__device__ __forceinline__ void gemm_phase(LAS unsigned char* lds, const int wid, const ProbT P, const Sched& S, const Epi& E) {
    const int lane = lane_id(), tid = wid * 64 + lane, wr = wid >> 2, wc = wid & 3, fr = lane & 15, fq = lane >> 4;
    constexpr int nt = ProbT::nt;
    unsigned voffA[2], voffB[2];
#pragma unroll
    for (int i = 0; i < 2; ++i) { int R, C; stage_rc(tid * 16 + i * 8192, R, C); const int Rb = Epi::PERM ? ((R & ~31) + perm32(R & 31)) : R;
        voffA[i] = (unsigned)(R * ProbT::lda + C) * 2u; voffB[i] = (unsigned)(Rb * ProbT::ldb + C) * 2u; }
    const size_t kstep = (size_t)(BK * 2);
    constexpr size_t hstepA = (size_t)HALF * ProbT::lda * 2, hstepB = (size_t)HALF * ProbT::ldb * 2;
    const unsigned ldsw = (unsigned)wid * 1024u;
    const int aoff = lds_byte(wr * 64 + fr, fq * 8), boff = lds_byte(wc * 32 + fr, fq * 8);
#define PG8_SA(b, h) (((b) * 2 + (h)) * HTB)
#define PG8_SB(b, h) ((4 + (b) * 2 + (h)) * HTB)
#define PG8_STAGE(bufoff, gbase, voff) do { _Pragma("unroll") for (int _i = 0; _i < 2; ++_i) \
        __builtin_amdgcn_global_load_lds((const unsigned*)((const char*)(gbase) + (voff)[_i]), (LAS unsigned*)(lds + (bufoff) + ldsw + _i * 8192), 16, 0, 0); } while (0)
#define PG8_LDA(dst, b, h) do { _Pragma("unroll") for (int m = 0; m < 4; ++m) _Pragma("unroll") for (int k = 0; k < 2; ++k) dst[m][k] = *(const LAS bf16x8*)(lds + PG8_SA(b, h) + aoff + m * 2048 + k * 1024); } while (0)
#define PG8_LDB(dst, b, h) do { _Pragma("unroll") for (int n = 0; n < 2; ++n) _Pragma("unroll") for (int k = 0; k < 2; ++k) dst[n][k] = *(const LAS bf16x8*)(lds + PG8_SB(b, h) + boff + n * 2048 + k * 1024); } while (0)
#define PG8_MMA(ai, bj, At, Bt) do { __builtin_amdgcn_s_setprio(1); _Pragma("unroll") for (int m = 0; m < 4; ++m) _Pragma("unroll") for (int n = 0; n < 2; ++n) _Pragma("unroll") for (int k = 0; k < 2; ++k) \
        acc[ai][bj][m][n] = __builtin_amdgcn_mfma_f32_16x16x32_bf16(Bt[n][k], At[m][k], acc[ai][bj][m][n], 0, 0, 0); __builtin_amdgcn_s_setprio(0); } while (0)
#define PG8_WAIT_V(n) asm volatile("s_waitcnt vmcnt(" #n ")" ::: "memory")
#define PG8_WAIT_L(n) asm volatile("s_waitcnt lgkmcnt(" #n ")" ::: "memory")
#define PG8_BAR __builtin_amdgcn_s_barrier()
#define PG8_SCHED __builtin_amdgcn_sched_barrier(0)
    Unit cur, nxt; int ui = 0;
    if (!S.next(0, cur)) return;
    f32x4 acc[2][2][4][2];
#pragma unroll
    for (int a = 0; a < 2; ++a)
#pragma unroll
        for (int b = 0; b < 2; ++b)
#pragma unroll
            for (int m = 0; m < 4; ++m)
#pragma unroll
                for (int n = 0; n < 2; ++n) acc[a][b][m][n] = (f32x4){0.f, 0.f, 0.f, 0.f};
    bf16x8 At[4][2], B0[2][2], B1[2][2];
    const char* cA = P.a_base(cur); const char* cB = P.b_base(cur);
    S.a_ready(cur);
    if constexpr (SP2) {
    PG8_STAGE(PG8_SB(0, 0), cB, voffB); PG8_STAGE(PG8_SB(0, 1), cB + hstepB, voffB); PG8_STAGE(PG8_SA(0, 0), cA, voffA); PG8_STAGE(PG8_SA(0, 1), cA + hstepA, voffA);
    if (wr == 1) PG8_BAR;
    PG8_WAIT_V(2); PG8_BAR;
    PG8_STAGE(PG8_SB(1, 0), cB + kstep, voffB); PG8_STAGE(PG8_SA(1, 0), cA + kstep, voffA); PG8_STAGE(PG8_SB(1, 1), cB + hstepB + kstep, voffB);
    PG8_WAIT_V(6); PG8_BAR;
    } else {
    PG8_STAGE(PG8_SB(0, 0), cB, voffB); PG8_STAGE(PG8_SA(0, 0), cA, voffA); PG8_STAGE(PG8_SB(0, 1), cB + hstepB, voffB); PG8_STAGE(PG8_SA(0, 1), cA + hstepA, voffA);
    if (wr == 1) PG8_BAR;
    PG8_WAIT_V(4); PG8_BAR;
    PG8_STAGE(PG8_SB(1, 0), cB + kstep, voffB); PG8_STAGE(PG8_SA(1, 0), cA + kstep, voffA); PG8_STAGE(PG8_SB(1, 1), cB + hstepB + kstep, voffB);
    PG8_WAIT_V(6); PG8_BAR;
    }
    for (;;) {
        const bool has_next = S.next(ui + 1, nxt);
        const char* nA = has_next ? P.a_base(nxt) : cA; const char* nB = has_next ? P.b_base(nxt) : cB;
        for (int t = 0; t < nt; t += 2) {
            const bool last = (t == nt - 2);
            const char* a1 = cA + (size_t)(t + 1) * kstep;
            const char* a2 = last ? nA : cA + (size_t)(t + 2) * kstep; const char* b2 = last ? nB : cB + (size_t)(t + 2) * kstep;
            const char* a3 = a2 + kstep; const char* b3 = b2 + kstep;
            if (last && has_next) S.a_ready(nxt);
            if constexpr (SP2) {
            PG8_LDB(B0, 0, 0); PG8_LDB(B1, 0, 1); PG8_SCHED; PG8_LDA(At, 0, 0); PG8_STAGE(PG8_SA(1, 1), a1 + hstepA, voffA);
            PG8_WAIT_V(8); PG8_WAIT_L(0); PG8_BAR; PG8_MMA(0, 0, At, B0); PG8_MMA(0, 1, At, B1); PG8_BAR; PG8_SCHED;
            PG8_LDA(At, 0, 1); PG8_STAGE(PG8_SB(0, 0), b2, voffB); PG8_STAGE(PG8_SB(0, 1), b2 + hstepB, voffB); PG8_STAGE(PG8_SA(0, 0), a2, voffA);
            PG8_WAIT_V(8); PG8_WAIT_L(0); PG8_BAR; PG8_MMA(1, 0, At, B0); PG8_MMA(1, 1, At, B1); PG8_BAR; PG8_SCHED;
            PG8_LDB(B0, 1, 0); PG8_LDB(B1, 1, 1); PG8_SCHED; PG8_LDA(At, 1, 0); PG8_STAGE(PG8_SA(0, 1), a2 + hstepA, voffA);
            PG8_WAIT_V(8); PG8_WAIT_L(0); PG8_BAR; PG8_MMA(0, 0, At, B0); PG8_MMA(0, 1, At, B1); PG8_BAR; PG8_SCHED;
            PG8_LDA(At, 1, 1); PG8_STAGE(PG8_SB(1, 0), b3, voffB); PG8_STAGE(PG8_SB(1, 1), b3 + hstepB, voffB); PG8_STAGE(PG8_SA(1, 0), a3, voffA);
            PG8_WAIT_V(8); PG8_WAIT_L(0); PG8_BAR; PG8_MMA(1, 0, At, B0); PG8_MMA(1, 1, At, B1); PG8_BAR; PG8_SCHED;
            } else {
            PG8_LDB(B0, 0, 0); PG8_SCHED; PG8_LDA(At, 0, 0); PG8_STAGE(PG8_SA(1, 1), a1 + hstepA, voffA);
            PG8_WAIT_L(8); PG8_BAR; PG8_WAIT_L(0); PG8_MMA(0, 0, At, B0); PG8_BAR; PG8_SCHED;
            PG8_LDB(B1, 0, 1); PG8_STAGE(PG8_SB(0, 0), b2, voffB);
            PG8_BAR; PG8_WAIT_L(0); PG8_MMA(0, 1, At, B1); PG8_BAR;
            PG8_LDA(At, 0, 1); PG8_STAGE(PG8_SA(0, 0), a2, voffA);
            PG8_BAR; PG8_WAIT_L(0); PG8_MMA(1, 0, At, B0); PG8_BAR; PG8_SCHED;
            PG8_STAGE(PG8_SB(0, 1), b2 + hstepB, voffB);
            PG8_WAIT_V(6); PG8_BAR; PG8_MMA(1, 1, At, B1); PG8_BAR;
            PG8_LDB(B0, 1, 0); PG8_SCHED; PG8_LDA(At, 1, 0); PG8_STAGE(PG8_SA(0, 1), a2 + hstepA, voffA);
            PG8_WAIT_L(8); PG8_BAR; PG8_WAIT_L(0); PG8_MMA(0, 0, At, B0); PG8_BAR; PG8_SCHED;
            PG8_LDB(B1, 1, 1); PG8_STAGE(PG8_SB(1, 0), b3, voffB);
            PG8_BAR; PG8_WAIT_L(0); PG8_MMA(0, 1, At, B1); PG8_BAR;
            PG8_LDA(At, 1, 1); PG8_STAGE(PG8_SA(1, 0), a3, voffA);
            PG8_BAR; PG8_WAIT_L(0); PG8_MMA(1, 0, At, B0); PG8_BAR; PG8_SCHED;
            PG8_STAGE(PG8_SB(1, 1), b3 + hstepB, voffB);
            PG8_WAIT_V(6); PG8_BAR; PG8_MMA(1, 1, At, B1); PG8_BAR;
            }
        }
        if constexpr (ALIGN_EPI) { if (wr == 0) PG8_BAR; }
        E(acc, cur, wr, wc); S.done(cur);
        if (!has_next) break;
#pragma unroll
        for (int a = 0; a < 2; ++a)
#pragma unroll
            for (int b = 0; b < 2; ++b)
#pragma unroll
                for (int m = 0; m < 4; ++m)
#pragma unroll
                    for (int n = 0; n < 2; ++n) acc[a][b][m][n] = (f32x4){0.f, 0.f, 0.f, 0.f};
        cur = nxt; cA = nA; cB = nB; ++ui;
        if constexpr (ALIGN_EPI) { if (wr == 1) PG8_BAR; }
    }
    PG8_WAIT_V(0);
    if constexpr (!ALIGN_EPI) { if (wr == 0) PG8_BAR; }
    PG8_BAR;
#undef PG8_SA
#undef PG8_SB
#undef PG8_STAGE
#undef PG8_LDA
#undef PG8_LDB
#undef PG8_MMA
#undef PG8_WAIT_V
#undef PG8_WAIT_L
#undef PG8_BAR
#undef PG8_SCHED
}

typedef const f32x4 (&AccRef)[2][2][4][2];
#define ROWG(ai, m) ({ int _r = (ai) * 128 + (m) * 16; asm volatile("" : "+v"(_r)); _r; })

struct EpiPlain {
    static constexpr bool PERM = true;
    bf16_t* O; int ldc, sb, spm, spn;
    __device__ __forceinline__ void operator()(AccRef acc, const Unit& u, int wr, int wc) const {
        const int lane_ = lane_id(), fr = lane_ & 15, fq = lane_ >> 4;
        bf16_t* base = O + (u.b * sb + u.pm * spm + u.pn * spn) + (wr * 64 + fr) * ldc + wc * 32 + fq * 8;
#pragma unroll
        for (int ai = 0; ai < 2; ++ai)
#pragma unroll
            for (int m = 0; m < 4; ++m)
#pragma unroll
                for (int bj = 0; bj < 2; ++bj) *(u32x4*)(base + (size_t)(ai * 128 + m * 16) * ldc + bj * 128) = pack8(acc[ai][bj][m][0], acc[ai][bj][m][1]);
    }
};

struct EpiF32Slab {
    static constexpr bool PERM = false;
    float* O; int ldc, sb, spm, spn;
    __device__ __forceinline__ void operator()(AccRef acc, const Unit& u, int wr, int wc) const {
        const int lane_ = lane_id(), fr = lane_ & 15, fq = lane_ >> 4;
        float* base = O + (u.b * sb + u.pm * spm + u.pn * spn) + (wr * 64 + fr) * ldc + wc * 32 + fq * 4;
#pragma unroll
        for (int ai = 0; ai < 2; ++ai)
#pragma unroll
            for (int m = 0; m < 4; ++m)
#pragma unroll
                for (int bj = 0; bj < 2; ++bj)
#pragma unroll
                    for (int n = 0; n < 2; ++n) *(f32x4*)(base + (size_t)(ai * 128 + m * 16) * ldc + bj * 128 + n * 16) = acc[ai][bj][m][n];
    }
};

struct EpiMain {
    static constexpr bool PERM = true;
    bf16_t* Z; bf16_t* PQ; bf16_t* KdT; const float* ropec; const float* ropes;
    __device__ __forceinline__ void operator()(AccRef acc, const Unit& u, int wr, int wc) const {
        const int lane_ = lane_id(), fr = lane_ & 15, fq = lane_ >> 4;
        const int pn = u.pn, lr0 = wr * 64 + fr, lc = wc * 32 + fq * 8;
        bf16_t* zb = Z + (size_t)(u.pm * 256 + lr0) * LDZ + pn * 256 + lc;
        if (pn >= 32 && pn < 64) {
            const bool isk = pn >= 48; const int head = (pn - 32) & 15; const float lg = c_lg2g[head];
#pragma unroll
            for (int ai = 0; ai < 2; ++ai)
#pragma unroll
                for (int m = 0; m < 4; ++m) {
                    const int rg = ROWG(ai, m), il = lr0 + rg, row = u.pm * 256 + il;
                    const f32x4 c0 = *(const f32x4*)(ropec + (size_t)row * 128 + lc), c1 = *(const f32x4*)(ropec + (size_t)row * 128 + lc + 4);
                    const f32x4 s0 = *(const f32x4*)(ropes + (size_t)row * 128 + lc), s1 = *(const f32x4*)(ropes + (size_t)row * 128 + lc + 4);
                    const f32x4 x10 = acc[ai][0][m][0], x11 = acc[ai][0][m][1], x20 = acc[ai][1][m][0], x21 = acc[ai][1][m][1];
                    const f32x4 y10 = x10 * c0 - x20 * s0, y11 = x11 * c1 - x21 * s1, y20 = x20 * c0 + x10 * s0, y21 = x21 * c1 + x11 * s1;
                    bf16_t* zr = zb + (size_t)rg * LDZ;
                    *(u32x4*)zr = pack8(y10, y11); *(u32x4*)(zr + 128) = pack8(y20, y21);
                    if (!isk) {
                        const float dq = __builtin_amdgcn_exp2f((float)(il + 1) * lg);
                        bf16_t* pq = PQ + ((size_t)head * SEQ + row) * 512 + 256 + lc;
                        *(u32x4*)pq = pack8(y10 * dq, y11 * dq); *(u32x4*)(pq + 128) = pack8(y20 * dq, y21 * dq);
                    } else {
                        const float dk = __builtin_amdgcn_exp2f((float)(255 - il) * lg);
                        bf16_t* kt = KdT + ((size_t)(head * NCH + u.pm) * 256 + lc) * 256 + il;
                        const u32x4 w1 = pack8(y10 * dk, y11 * dk), w2 = pack8(y20 * dk, y21 * dk);
                        kt[0 * 256] = (bf16_t)(w1.x & 0xffffu); kt[1 * 256] = (bf16_t)(w1.x >> 16); kt[2 * 256] = (bf16_t)(w1.y & 0xffffu); kt[3 * 256] = (bf16_t)(w1.y >> 16);
                        kt[4 * 256] = (bf16_t)(w1.z & 0xffffu); kt[5 * 256] = (bf16_t)(w1.z >> 16); kt[6 * 256] = (bf16_t)(w1.w & 0xffffu); kt[7 * 256] = (bf16_t)(w1.w >> 16);
                        bf16_t* kt2 = kt + 128 * 256;
                        kt2[0 * 256] = (bf16_t)(w2.x & 0xffffu); kt2[1 * 256] = (bf16_t)(w2.x >> 16); kt2[2 * 256] = (bf16_t)(w2.y & 0xffffu); kt2[3 * 256] = (bf16_t)(w2.y >> 16);
                        kt2[4 * 256] = (bf16_t)(w2.z & 0xffffu); kt2[5 * 256] = (bf16_t)(w2.z >> 16); kt2[6 * 256] = (bf16_t)(w2.w & 0xffffu); kt2[7 * 256] = (bf16_t)(w2.w >> 16);
                    }
                    asm volatile("" ::: "memory");
                }
        } else {
            const int act = (pn < 16) ? 0 : (pn < 96) ? 1 : (pn < 112) ? 0 : (pn < 128) ? 1 : 2;
            if (act == 0) {
#pragma unroll
                for (int ai = 0; ai < 2; ++ai)
#pragma unroll
                    for (int m = 0; m < 4; ++m) { const int rg = ROWG(ai, m);
#pragma unroll
                        for (int bj = 0; bj < 2; ++bj) *(u32x4*)(zb + (size_t)rg * LDZ + bj * 128) = pack8(acc[ai][bj][m][0], acc[ai][bj][m][1]); }
            } else {
                const bool is_silu = act == 1;
#pragma unroll
                for (int ai = 0; ai < 2; ++ai)
#pragma unroll
                    for (int m = 0; m < 4; ++m) { const int rg = ROWG(ai, m);
#pragma unroll
                        for (int bj = 0; bj < 2; ++bj) { f32x4 v0 = acc[ai][bj][m][0], v1 = acc[ai][bj][m][1];
#pragma unroll
                            for (int e = 0; e < 4; ++e) { const float s0 = sigm(v0[e]), s1 = sigm(v1[e]); v0[e] = is_silu ? v0[e] * s0 : s0; v1[e] = is_silu ? v1[e] * s1 : s1; }
                            *(u32x4*)(zb + (size_t)rg * LDZ + bj * 128) = pack8(v0, v1); }
                        asm volatile("" ::: "memory"); }
            }
        }
    }
};

struct EpiVt {
    static constexpr bool PERM = true;
    bf16_t* VS;
    __device__ __forceinline__ void operator()(AccRef acc, const Unit& u, int wr, int wc) const {
        const int lane_ = lane_id(), fr = lane_ & 15, fq = lane_ >> 4;
        bf16_t* base = VS + ((size_t)((u.pm >> 1) * NCH + u.pn) * 512 + (u.pm & 1) * 256 + wr * 64 + fr) * 512 + wc * 32 + fq * 8;
#pragma unroll
        for (int ai = 0; ai < 2; ++ai)
#pragma unroll
            for (int m = 0; m < 4; ++m)
#pragma unroll
                for (int bj = 0; bj < 2; ++bj) *(u32x4*)(base + (size_t)(ai * 128 + m * 16) * 512 + bj * 128) = pack8(acc[ai][bj][m][0], acc[ai][bj][m][1]);
    }
};

struct EpiScores {
    static constexpr bool PERM = true;
    bf16_t* PQ;
    __device__ __forceinline__ void operator()(AccRef acc, const Unit& u, int wr, int wc) const {
        const int lane_ = lane_id(), fr = lane_ & 15, fq = lane_ >> 4;
        const float lg = c_lg2g[u.b]; const int lr0 = wr * 64 + fr, lc = wc * 32 + fq * 8;
        bf16_t* base = PQ + ((size_t)u.b * SEQ + u.pm * 256 + lr0) * 512 + lc;
        float gp[8];
#pragma unroll
        for (int e = 0; e < 8; ++e) gp[e] = __builtin_amdgcn_exp2f((float)(7 - e) * lg);
#pragma unroll
        for (int ai = 0; ai < 2; ++ai)
#pragma unroll
            for (int m = 0; m < 4; ++m) { const int rg = ROWG(ai, m);
#pragma unroll
                for (int bj = 0; bj < 2; ++bj) {
                    const int dd = (lr0 + rg) - (lc + bj * 128);
                    const float g0 = __builtin_amdgcn_exp2f((float)(dd - 7) * lg);
                    f32x4 v0 = acc[ai][bj][m][0], v1 = acc[ai][bj][m][1];
#pragma unroll
                    for (int e = 0; e < 4; ++e) { v0[e] = (dd - e) >= 0 ? v0[e] * (g0 * gp[e]) : 0.f; v1[e] = (dd - 4 - e) >= 0 ? v1[e] * (g0 * gp[4 + e]) : 0.f; }
                    *(u32x4*)(base + (size_t)rg * 512 + bj * 128) = pack8(v0, v1);
                }
                asm volatile("" ::: "memory");
            }
    }
};

struct EpiRetOut {
    static constexpr bool PERM = true;
    bf16_t* O; float* RS;
    __device__ __forceinline__ void operator()(AccRef acc, const Unit& u, int wr, int wc) const {
        const int lane_ = lane_id(), fr = lane_ & 15, fq = lane_ >> 4;
        const int row0 = u.pm * 256 + wr * 64 + fr;
        bf16_t* base = O + (size_t)row0 * 8192 + u.b * 512 + u.pn * 256 + wc * 32 + fq * 8;
#pragma unroll
        for (int ai = 0; ai < 2; ++ai)
#pragma unroll
            for (int m = 0; m < 4; ++m) { const int rg = ROWG(ai, m);
                float s = 0.f;
#pragma unroll
                for (int bj = 0; bj < 2; ++bj) { const f32x4 v0 = acc[ai][bj][m][0], v1 = acc[ai][bj][m][1];
                    s += (v0[0] * v0[0] + v0[1] * v0[1]) + (v0[2] * v0[2] + v0[3] * v0[3]) + (v1[0] * v1[0] + v1[1] * v1[1]) + (v1[2] * v1[2] + v1[3] * v1[3]);
                    *(u32x4*)(base + (size_t)rg * 8192 + bj * 128) = pack8(v0, v1); }
                s += shx(s, lane_, 16); s += shx(s, lane_, 32);
                if (fq == 0) atomic_addf(RS + (size_t)u.b * SEQ + row0 + rg, s);
                asm volatile("" ::: "memory");
            }
    }
};

struct EpiMemS {
    static constexpr bool PERM = true;
    bf16_t* Pm; float* RSm;
    __device__ __forceinline__ void operator()(AccRef acc, const Unit& u, int wr, int wc) const {
        const int lane_ = lane_id(), fr = lane_ & 15, fq = lane_ >> 4;
        const int row0 = u.pm * 256 + wr * 64 + fr;
        bf16_t* base = Pm + ((size_t)u.b * SEQ + row0) * 256 + wc * 32 + fq * 8;
#pragma unroll
        for (int ai = 0; ai < 2; ++ai)
#pragma unroll
            for (int m = 0; m < 4; ++m) { const int rg = ROWG(ai, m);
                float s = 0.f;
#pragma unroll
                for (int bj = 0; bj < 2; ++bj) { f32x4 v0 = acc[ai][bj][m][0], v1 = acc[ai][bj][m][1];
#pragma unroll
                    for (int e = 0; e < 4; ++e) { v0[e] = __builtin_amdgcn_exp2f(fminf(v0[e], 80.f) * 1.44269504f); v1[e] = __builtin_amdgcn_exp2f(fminf(v1[e], 80.f) * 1.44269504f); }
                    const u32x4 w = pack8(v0, v1);
                    s += (bf_lo(w.x) + bf_hi(w.x)) + (bf_lo(w.y) + bf_hi(w.y)) + (bf_lo(w.z) + bf_hi(w.z)) + (bf_lo(w.w) + bf_hi(w.w));
                    *(u32x4*)(base + (size_t)rg * 256 + bj * 128) = w; }
                s += shx(s, lane_, 16); s += shx(s, lane_, 32);
                if (fq == 0) atomic_addf(RSm + (size_t)u.b * SEQ + row0 + rg, s);
                asm volatile("" ::: "memory");
            }
    }
};

struct EpiMemPV {
    static constexpr bool PERM = true;
    const float* RSm; const bf16_t* Zg; bf16_t* Out;
    __device__ __forceinline__ void operator()(AccRef acc, const Unit& u, int wr, int wc) const {
        const int lane_ = lane_id(), fr = lane_ & 15, fq = lane_ >> 4;
        const int row0 = u.pm * 256 + wr * 64 + fr, col0 = u.b * 1024 + u.pn * 256 + wc * 32 + fq * 8;
#pragma unroll
        for (int ai = 0; ai < 2; ++ai)
#pragma unroll
            for (int m = 0; m < 4; ++m) { const int row = row0 + ROWG(ai, m);
                const float rinv = 1.0f / RSm[(size_t)u.b * SEQ + row];
#pragma unroll
                for (int bj = 0; bj < 2; ++bj) { const u32x4 g = *(const u32x4*)(Zg + (size_t)row * LDZ + col0 + bj * 128);
                    *(u32x4*)(Out + (size_t)row * DM + col0 + bj * 128) = pack8(acc[ai][bj][m][0] * rinv * bf4_lo(g), acc[ai][bj][m][1] * rinv * bf4_hi(g)); }
                asm volatile("" ::: "memory"); }
    }
};

struct EpiPool {
    static constexpr bool PERM = true;
    const float* scale; const bf16_t* Zg; bf16_t* Out;
    __device__ __forceinline__ void operator()(AccRef acc, const Unit& u, int wr, int wc) const {
        const int lane_ = lane_id(), fr = lane_ & 15, fq = lane_ >> 4;
        const int row0 = u.pm * 256 + wr * 64 + fr, col0 = u.b * 1024 + u.pn * 256 + wc * 32 + fq * 8;
        f32x4 sc[2][2];
#pragma unroll
        for (int bj = 0; bj < 2; ++bj) { sc[bj][0] = *(const f32x4*)(scale + col0 + bj * 128); sc[bj][1] = *(const f32x4*)(scale + col0 + bj * 128 + 4); }
#pragma unroll
        for (int ai = 0; ai < 2; ++ai)
#pragma unroll
            for (int m = 0; m < 4; ++m) { const int row = row0 + ROWG(ai, m);
#pragma unroll
                for (int bj = 0; bj < 2; ++bj) { const u32x4 g = *(const u32x4*)(Zg + (size_t)row * LDZ + col0 + bj * 128);
                    *(u32x4*)(Out + (size_t)row * DM + col0 + bj * 128) = pack8(acc[ai][bj][m][0] * sc[bj][0] * bf4_lo(g), acc[ai][bj][m][1] * sc[bj][1] * bf4_hi(g)); }
                asm volatile("" ::: "memory"); }
    }
};

template <int STAGE> struct EpiProj {
    static constexpr bool PERM = true;
    const bf16_t* Zg; float* Mg; bf16_t* Merged;
    __device__ __forceinline__ void operator()(AccRef acc, const Unit& u, int wr, int wc) const {
        const int lane_ = lane_id(), fr = lane_ & 15, fq = lane_ >> 4;
        const int row0 = u.pm * 256 + wr * 64 + fr, col0 = u.pn * 256 + wc * 32 + fq * 8;
#pragma unroll
        for (int ai = 0; ai < 2; ++ai)
#pragma unroll
            for (int mp = 0; mp < 2; ++mp) {
                int row[2]; u32x4 g[2][2]; f32x4 p0[2][2], p1[2][2];
#pragma unroll
                for (int k = 0; k < 2; ++k) { row[k] = row0 + ROWG(ai, 2 * mp + k);
#pragma unroll
                    for (int bj = 0; bj < 2; ++bj) { g[k][bj] = *(const u32x4*)(Zg + (size_t)row[k] * LDZ + col0 + bj * 128);
                        if (STAGE > 0) { const float* mp_ = Mg + (size_t)row[k] * DM + col0 + bj * 128; p0[k][bj] = *(const f32x4*)mp_; p1[k][bj] = *(const f32x4*)(mp_ + 4); } } }
#pragma unroll
                for (int k = 0; k < 2; ++k)
#pragma unroll
                    for (int bj = 0; bj < 2; ++bj) { const int m = 2 * mp + k;
                        f32x4 v0 = acc[ai][bj][m][0] * bf4_lo(g[k][bj]), v1 = acc[ai][bj][m][1] * bf4_hi(g[k][bj]);
                        if (STAGE > 0) { v0 += p0[k][bj]; v1 += p1[k][bj]; }
                        float* mq = Mg + (size_t)row[k] * DM + col0 + bj * 128;
                        if (STAGE < 2) { *(f32x4*)mq = v0; *(f32x4*)(mq + 4) = v1; }
                        else *(u32x4*)(Merged + (size_t)row[k] * DM + col0 + bj * 128) = pack8(v0, v1); }
                asm volatile("" ::: "memory"); }
    }
};

struct EpiOutProj {
    static constexpr bool PERM = false;
    const float* x; float* out; float* RSo;
    __device__ __forceinline__ void operator()(AccRef acc, const Unit& u, int wr, int wc) const {
        const int lane_ = lane_id(), fr = lane_ & 15, fq = lane_ >> 4;
        const int row0 = u.pm * 256 + wr * 64 + fr, col0 = u.pn * 256 + wc * 32 + fq * 4;
#pragma unroll
        for (int ai = 0; ai < 2; ++ai)
#pragma unroll
            for (int m = 0; m < 4; ++m) { const int row = row0 + ROWG(ai, m); float s = 0.f;
#pragma unroll
                for (int bj = 0; bj < 2; ++bj)
#pragma unroll
                    for (int n = 0; n < 2; ++n) { const size_t off = (size_t)row * DM + col0 + bj * 128 + n * 16;
                        const f32x4 v = *(const f32x4*)(x + off) + acc[ai][bj][m][n]; *(f32x4*)(out + off) = v;
                        s += (v[0] * v[0] + v[1] * v[1]) + (v[2] * v[2] + v[3] * v[3]); }
                s += shx(s, lane_, 16); s += shx(s, lane_, 32);
                if (fq == 0) atomic_addf(RSo + row, s);
                asm volatile("" ::: "memory"); }
    }
};
}

#define XB_TMO      128
#define XB_XCNT(j)  (256  + 64 * (j))
#define XB_XSUB(j)  (1280 + 64 * (j))
#define XB_XGEN(j)  (2304 + 64 * (j))
#define XB_TOP      3328
#define XB_TOPGEN   3392
#define XCD_BAR_WORDS 3456
#define XB_SPIN_CAP (1u << 18)
__device__ __forceinline__ unsigned xb_ld(unsigned* p)              { return __hip_atomic_load(p, __ATOMIC_RELAXED, __HIP_MEMORY_SCOPE_AGENT); }
__device__ __forceinline__ unsigned xb_add(unsigned* p, unsigned v) { return __hip_atomic_fetch_add(p, v, __ATOMIC_RELAXED, __HIP_MEMORY_SCOPE_AGENT); }
__device__ __forceinline__ unsigned xb_xcc_id() { return (unsigned)__builtin_amdgcn_s_getreg((3 << 11) | 20) & 0xFu; }
#define XB_SPIN(cond, bar) do { unsigned _sp = 0; while (cond) { __builtin_amdgcn_s_sleep(1); \
    if ((++_sp & 255u) == 0u) { if (xb_ld(&(bar)[XB_TMO])) break; if (_sp > XB_SPIN_CAP) { atomicAdd(&(bar)[XB_TMO], 1u); break; } } } } while (0)
struct XcdBarrier { unsigned* bar; unsigned x; volatile LAS unsigned* st; };
__device__ __forceinline__ XcdBarrier xcd_barrier_post(unsigned* bar, volatile LAS unsigned* st, bool leader) {
    XcdBarrier b; b.bar = bar; b.x = xb_xcc_id(); b.st = st;
    if (leader) (void)xb_add(&bar[XB_XCNT(b.x)], 1u);
    return b;
}
__device__ __forceinline__ void xcd_barrier_complete(unsigned* bar, unsigned x, unsigned& nloc, unsigned& nx) {
    const unsigned G = gridDim.x * gridDim.y * gridDim.z;
    unsigned sum, cnt, mine, sp = 0u;
    for (;;) {
        sum = 0u; cnt = 0u; mine = 0u;
#pragma unroll
        for (unsigned j = 0; j < 16; ++j) { const unsigned c = xb_ld(&bar[XB_XCNT(j)]); sum += c; cnt += (c > 0u) ? 1u : 0u; mine = (j == x) ? c : mine; }
        if (sum == G) break;
        __builtin_amdgcn_s_sleep(1);
        if ((++sp & 255u) == 0u) { if (xb_ld(&bar[XB_TMO])) break; if (sp > XB_SPIN_CAP) { atomicAdd(&bar[XB_TMO], 1u); break; } }
    }
    nloc = mine > 0u ? mine : 1u; nx = cnt > 0u ? cnt : 1u;
}
__device__ __forceinline__ void xcd_barrier(const XcdBarrier& b, bool leader) {
    asm volatile("s_waitcnt vmcnt(0)" ::: "memory");
    __syncthreads();
    if (leader) {
        unsigned* bar = b.bar;
        __builtin_amdgcn_s_waitcnt(0);
        unsigned nloc = b.st[0], nx = b.st[1];
        if (nloc == 0u) { xcd_barrier_complete(bar, b.x, nloc, nx); b.st[0] = nloc; b.st[1] = nx; }
        const unsigned old = xb_add(&bar[XB_XSUB(b.x)], 1u);
        const unsigned gen = old / nloc;
        if (old + 1u == (gen + 1u) * nloc) {
            __builtin_amdgcn_fence(__ATOMIC_RELEASE, "agent");
            asm volatile("s_waitcnt vmcnt(0)" ::: "memory");
            const unsigned og = xb_add(&bar[XB_TOP], 1u);
            const unsigned tg = og / nx;
            if (og + 1u == (tg + 1u) * nx) xb_add(&bar[XB_TOPGEN], 1u);
            else XB_SPIN(xb_ld(&bar[XB_TOPGEN]) == tg, bar);
            __builtin_amdgcn_fence(__ATOMIC_ACQUIRE, "agent");
            xb_add(&bar[XB_XGEN(b.x)], 1u);
            asm volatile("s_waitcnt vmcnt(0)" ::: "memory");
        } else {
            XB_SPIN(xb_ld(&bar[XB_XGEN(b.x)]) == gen, bar);
            __builtin_amdgcn_fence(__ATOMIC_ACQUIRE, "agent");
            asm volatile("s_waitcnt vmcnt(0)" ::: "memory");
        }
    }
    __syncthreads();
}

#define LDS_WAIT() asm volatile("s_waitcnt lgkmcnt(0)" ::: "memory")
__device__ __forceinline__ void transpose_item(const float* W, int ldw, int col0, int k0, bf16_t* WT, int ldt, int row0, float scale, LAS float* scr, int lane) {
    const int kr = lane >> 4, n4 = (lane & 15) * 4;
    const float* src = W + (size_t)(k0 + kr) * ldw + col0 + n4;
    f32x4 v[16];
#pragma unroll
    for (int i = 0; i < 16; ++i) v[i] = __builtin_nontemporal_load((const f32x4*)(src + (size_t)(4 * i) * ldw));
#pragma unroll
    for (int i = 0; i < 16; ++i) { LAS float* d = scr + (4 * i + kr) * 65 + n4; d[0] = v[i][0]; d[1] = v[i][1]; d[2] = v[i][2]; d[3] = v[i][3]; }
    LDS_WAIT(); asm volatile("" ::: "memory");
    const int c = lane & 7, nl = lane >> 3;
#pragma unroll
    for (int j = 0; j < 8; ++j) { const int n = nl + 8 * j; const LAS float* q = scr + (8 * c) * 65 + n;
        u32x4 o; o.x = cvt_pk_bf16(q[0 * 65] * scale, q[1 * 65] * scale); o.y = cvt_pk_bf16(q[2 * 65] * scale, q[3 * 65] * scale); o.z = cvt_pk_bf16(q[4 * 65] * scale, q[5 * 65] * scale); o.w = cvt_pk_bf16(q[6 * 65] * scale, q[7 * 65] * scale);
        *(u32x4*)(WT + (size_t)(row0 + n) * ldt + k0 + 8 * c) = o; }
    LDS_WAIT(); asm volatile("" ::: "memory");
}
__device__ __forceinline__ void transpose_job(const float* W, int K, int ldw, int coff, int ncols, bf16_t* WT, int roff, float scale, LAS float* scr, int lane, int gw, int ngw) {
    const int nblk = ncols / 64, items = (K / 64) * nblk;
    for (int it = gw; it < items; it += ngw) { const int kb = it / nblk, nb = it % nblk;
        transpose_item(W, ldw, coff + 64 * nb, 64 * kb, WT, K, roff + 64 * nb, scale, scr, lane); }
}
__device__ __forceinline__ void rms_row_to_bf16(const float* xrow, const float* g, bf16_t* orow, int lane) {
    const f32x4* xr = (const f32x4*)xrow + lane; const f32x4* gr = (const f32x4*)g + lane;
    f32x4 v[16]; float s = 0.f;
#pragma unroll
    for (int j = 0; j < 16; ++j) { v[j] = xr[64 * j]; s += (v[j][0] * v[j][0] + v[j][1] * v[j][1]) + (v[j][2] * v[j][2] + v[j][3] * v[j][3]); }
    const float rstd = 1.0f / sqrtf(wave_sum(s, lane) * (1.0f / DM) + NORM_EPS);
    u32x2* o8 = (u32x2*)orow + lane;
#pragma unroll
    for (int j = 0; j < 16; ++j) { const f32x4 gg = gr[64 * j]; u32x2 w; w.x = cvt_pk_bf16(v[j][0] * rstd * gg[0], v[j][1] * rstd * gg[1]); w.y = cvt_pk_bf16(v[j][2] * rstd * gg[2], v[j][3] * rstd * gg[3]); o8[64 * j] = w; }
}

struct Args { const float* in[14]; float* out; unsigned char* ws; };
#define WSP(type, off) ((type*)(ws + (off)))
__global__ void __launch_bounds__(NWAVES * 64, 2) fwd(Args args) {
    extern __shared__ __attribute__((aligned(16))) unsigned char lds_raw[];
    LAS unsigned char* lds = (LAS unsigned char*)lds_raw;
    const int G = gridDim.x, bx = blockIdx.x;
    unsigned char* const ws = args.ws;
    unsigned* const ctl = (unsigned*)(ws + WS_CTL);
    using pg8::Prob; using pg8::gemm_phase;

    const int wave = __builtin_amdgcn_readfirstlane((int)threadIdx.x >> 6);
    for (int u = threadIdx.x; u < (LDS_BYTES - LDSCTL_OFF) / 4; u += NWAVES * 64) ((LAS unsigned*)(lds + LDSCTL_OFF))[u] = 0u;
    __syncthreads();
    (void)xcd_barrier_post(ctl + CW_BAR, (volatile LAS unsigned*)(lds + MISC_OFF) + 8, wave == 0 && lane_id() == 0);
#define GRID_BAR() do { XcdBarrier _b; _b.bar = (unsigned*)(args.ws + WS_CTL) + CW_BAR; _b.x = xb_xcc_id(); _b.st = (volatile LAS unsigned*)(lds + MISC_OFF) + 8; xcd_barrier(_b, wave == 0 && lane_id() == 0); } while (0)
#define TIDS() const int lane = lane_id(), tid = wave * 64 + lane; \
    const int gw = bx * NWAVES + wave, ngw = G * NWAVES; const size_t gt = (size_t)bx * (NWAVES * 64) + tid, ngt = (size_t)G * (NWAVES * 64); (void)lane; (void)gw; (void)ngw; (void)gt; (void)ngt

    {
        TIDS();
        const float* w_in = args.in[4];
        LAS float* scr = (LAS float*)(lds + wave * TR_TILE_BYTES);
        bf16_t* WtA = WSP(bf16_t, WS_WTA);
        transpose_job(w_in, DM, 53248, 0, 12288, WtA, 0, 1.0f, scr, lane, gw, ngw);
        transpose_job(w_in, DM, 53248, 12288, 4096, WtA, 12288, 0.0625f, scr, lane, gw, ngw);
        transpose_job(w_in, DM, 53248, 16384, 8192, WSP(bf16_t, WS_WTV), 0, 1.0f, scr, lane, gw, ngw);
        transpose_job(w_in, DM, 53248, 24576, 8192, WtA, 16384, 1.0f, scr, lane, gw, ngw);
        transpose_job(w_in, DM, 53248, 32768, 4096, WtA, 24576, 0.03125f, scr, lane, gw, ngw);
        transpose_job(w_in, DM, 53248, 36864, 16384, WtA, 28672, 1.0f, scr, lane, gw, ngw);
#pragma unroll 1
        for (int g = 0; g < 4; ++g) transpose_job(args.in[5] + (size_t)g * 1024 * 1024, 1024, 1024, 0, 1024, WSP(bf16_t, WS_WG) + (size_t)g * 1024 * 1024, 0, 1.0f, scr, lane, gw, ngw);
        transpose_job(args.in[7], DM, DM, 0, DM, WSP(bf16_t, WS_WK), 0, 1.0f, scr, lane, gw, ngw);
        transpose_job(args.in[8], DM, DM, 0, DM, WSP(bf16_t, WS_WV), 0, 1.0f, scr, lane, gw, ngw);
        transpose_job(args.in[9], DM, DM, 0, DM, WSP(bf16_t, WS_WPP), 0, 1.0f, scr, lane, gw, ngw);
        transpose_job(args.in[10], 8192, DM, 0, DM, WSP(bf16_t, WS_WPR), 0, 1.0f, scr, lane, gw, ngw);
        transpose_job(args.in[11], DM, DM, 0, DM, WSP(bf16_t, WS_WPM), 0, 1.0f, scr, lane, gw, ngw);
        transpose_job(args.in[12], DM, DM, 0, DM, WSP(bf16_t, WS_WO), 0, 1.0f, scr, lane, gw, ngw);
        for (int m = gw; m < SEQ + MEML; m += ngw) {
            if (m < SEQ) rms_row_to_bf16(args.in[0] + (size_t)m * DM, args.in[2], WSP(bf16_t, WS_H) + (size_t)m * DM, lane);
            else rms_row_to_bf16(args.in[1] + (size_t)(m - SEQ) * DM, args.in[3], WSP(bf16_t, WS_MEMN) + (size_t)(m - SEQ) * DM, lane);
        }
        float* ropec = WSP(float, WS_ROPE); float* ropes = ropec + (size_t)SEQ * 128;
        for (size_t i = gt; i < (size_t)SEQ * 128; i += ngt) {
            const int pos = (int)(i >> 7), fi = (int)(i & 127);
            const float ang = (float)pos * c_inv[fi];
            const double rev = (double)ang * 0.15915494309189533577; const float fr_ = (float)(rev - __builtin_rint(rev));
            ropec[i] = __builtin_amdgcn_cosf(fr_); ropes[i] = __builtin_amdgcn_sinf(fr_);
        }
    }
    GRID_BAR();

    {
        { Prob<DM, DM, 8, 0, 0, 512, 0, 256 * DM, 512> p{WSP(bf16_t, WS_MEMN), WSP(bf16_t, WS_WK)}; pg8::BatchOrder S; S.init(8, 1, 16, G, bx);
          pg8::EpiF32Slab E{WSP(float, WS_KMP), DM, MEML * DM, 0, 256}; gemm_phase(lds, wave, p, S, E); }
        { Prob<DM, DM, 8, 256 * DM, 0, 512, 0, 0, 512> p{WSP(bf16_t, WS_WV), WSP(bf16_t, WS_MEMN)}; pg8::BatchOrder S; S.init(8, 16, 1, G, bx >= 128 ? bx - 128 : (1 << 20));
          pg8::EpiF32Slab E{WSP(float, WS_VMTP), 256, MEML * DM, 256 * 256, 0}; gemm_phase(lds, wave, p, S, E); }
        { Prob<DM, DM, DM / 64, 256 * DM, 0, 0, 0, 256 * DM, 0> p{WSP(bf16_t, WS_H), WSP(bf16_t, WS_WTA)}; pg8::StaticOrder S; S.init(SEQ / 256, LDZ / 256, G, bx);
          pg8::EpiMain E{WSP(bf16_t, WS_Z), WSP(bf16_t, WS_PQ), WSP(bf16_t, WS_KDT), WSP(float, WS_ROPE), WSP(float, WS_ROPE) + (size_t)SEQ * 128}; gemm_phase<BIG_ALIGN, BIG_SP2>(lds, wave, p, S, E); }
        { Prob<DM, DM, DM / 64, 256 * DM, 0, 0, 0, 256 * DM, 0> p{WSP(bf16_t, WS_WTV), WSP(bf16_t, WS_H)}; pg8::StaticOrder S; S.init(8192 / 256, SEQ / 256, G, bx);
          pg8::EpiVt E{WSP(bf16_t, WS_VS)}; gemm_phase<BIG_ALIGN, BIG_SP2>(lds, wave, p, S, E); }
    }
    GRID_BAR();

    {
        {
            TIDS();
            const float* slab = WSP(float, WS_KMP); bf16_t* dst = WSP(bf16_t, WS_KM);
            for (size_t i = gt; i < (size_t)2 * MEML * DM / 4; i += ngt) {
                const size_t which = i / (MEML * DM / 4), off = (i % (MEML * DM / 4)) * 4;
                const float* sp = slab + which * ((size_t)8 * MEML * DM) + off;
                f32x4 a = *(const f32x4*)sp;
#pragma unroll
                for (int k = 1; k < 8; ++k) a += *(const f32x4*)(sp + (size_t)k * MEML * DM);
                u32x2 w; w.x = cvt_pk_bf16(a[0], a[1]); w.y = cvt_pk_bf16(a[2], a[3]);
                *(u32x2*)(dst + which * ((size_t)MEML * DM) + off) = w;
            }
        }
        {
            TIDS();
            const bf16_t* Z = WSP(bf16_t, WS_Z); bf16_t* Mixed = WSP(bf16_t, WS_MIXED);
            for (size_t i = gt; i < (size_t)(SEQ / 32) * 512; i += ngt) {
                const int c8 = (int)(i & 511), t0 = (int)(i >> 9) * 32, w = 2 << (c8 >> 7);
                const bf16_t* up = Z + ZO_U + c8 * 8;
                f32x4 s0 = (f32x4){0.f, 0.f, 0.f, 0.f}, s1 = s0;
#pragma unroll
                for (int k = 1; k <= 16; ++k) { const int tr = t0 - k; if (k <= w && tr >= 0) {     const u32x4 v = *(const u32x4*)(up + (size_t)tr * LDZ); s0 += bf4_lo(v); s1 += bf4_hi(v); } }
#pragma unroll 1
                for (int tt = 0; tt < 32; tt += 8) {
                    u32x4 a[8], b[8];
#pragma unroll
                    for (int k = 0; k < 8; ++k) a[k] = *(const u32x4*)(up + (size_t)(t0 + tt + k) * LDZ);
#pragma unroll
                    for (int k = 0; k < 8; ++k) { const int tr = t0 + tt + k - w; b[k] = (u32x4){0u, 0u, 0u, 0u}; if (tr >= 0) b[k] = *(const u32x4*)(up + (size_t)tr * LDZ); }
#pragma unroll
                    for (int k = 0; k < 8; ++k) { const int t = t0 + tt + k; const f32x4 u0 = bf4_lo(a[k]), u1 = bf4_hi(a[k]);
                        s0 += u0 - bf4_lo(b[k]); s1 += u1 - bf4_hi(b[k]);
                        const float rc = 1.0f / (float)((t + 1) < w ? (t + 1) : w);
                        *(u32x4*)(Mixed + (size_t)t * DM + c8 * 8) = pack8(s0 * rc - u0, s1 * rc - u1); }
                }
            }
        }
        { Prob<512, 256, 4, 512 * 512, 256 * 512, NCH * 512 * 512, 256 * 256, 0, NCH * 256 * 256> p{WSP(bf16_t, WS_VS), WSP(bf16_t, WS_KDT)}; pg8::BatchOrder S; S.init(NH, NCH, 2, G, bx);
          pg8::EpiPlain E{WSP(bf16_t, WS_KVT), 256, NCH * 512 * 256, 512 * 256, 256 * 256}; gemm_phase(lds, wave, p, S, E); }
        { Prob<LDZ, LDZ, 4, 256 * LDZ, 0, 256, 256 * LDZ, 0, 256> p{WSP(bf16_t, WS_Z) + ZO_Q, WSP(bf16_t, WS_Z) + ZO_K}; pg8::BatchOrder S; S.init(NH, NCH, 1, G, bx);
          pg8::EpiScores E{WSP(bf16_t, WS_PQ)}; gemm_phase(lds, wave, p, S, E); }
    }
    GRID_BAR();

    {
        {
            TIDS();
            for (size_t i = gt; i < (size_t)NH * 512 * 32; i += ngt) {
                const int d8 = (int)(i & 31), e = (int)((i >> 5) & 511), h = (int)(i >> 14);
                const float gc = __builtin_amdgcn_exp2f(256.0f * c_lg2g[h]);
                f32x4 s0 = (f32x4){0.f, 0.f, 0.f, 0.f}, s1 = s0;
                const bf16_t* kv = WSP(bf16_t, WS_KVT) + ((size_t)(h * NCH) * 512 + e) * 256 + d8 * 8;
                bf16_t* st = WSP(bf16_t, WS_VS) + ((size_t)(h * NCH) * 512 + e) * 512 + 256 + d8 * 8;
#pragma unroll 4
                for (int n = 0; n < NCH; ++n) {
                    *(u32x4*)(st + (size_t)n * 512 * 512) = pack8(s0, s1);
                    const u32x4 v = *(const u32x4*)(kv + (size_t)n * 512 * 256);
                    s0 = s0 * gc + bf4_lo(v); s1 = s1 * gc + bf4_hi(v);
                }
            }
        }
        { Prob<DM, 1024, 16, 256 * DM, 0, 1024, 0, 256 * 1024, 1024 * 1024> p{WSP(bf16_t, WS_MIXED), WSP(bf16_t, WS_WG)}; pg8::BatchOrder S; S.init(4, SEQ / 256, 4, G, bx);
          pg8::EpiPool E{args.in[6], WSP(bf16_t, WS_Z) + ZO_SGP, WSP(bf16_t, WS_POOLOUT)}; gemm_phase(lds, wave, p, S, E); }
        { Prob<LDZ, DM, 16, 256 * LDZ, 0, 1024, 0, 0, 1024> p{WSP(bf16_t, WS_Z) + ZO_QM, WSP(bf16_t, WS_KM)}; pg8::BatchOrder S; S.init(4, SEQ / 256, 1, G, bx);
          pg8::EpiMemS E{WSP(bf16_t, WS_PM), WSP(float, CTL_RSM)}; gemm_phase(lds, wave, p, S, E); }
    }
    GRID_BAR();

    {
        { Prob<512, 512, 8, 256 * 512, 0, SEQ * 512, 512 * 512, 256 * 512, NCH * 512 * 512> p{WSP(bf16_t, WS_PQ), WSP(bf16_t, WS_VS)}; pg8::BatchOrder S; S.init(NH, NCH, 2, G, bx);
        pg8::EpiRetOut E{WSP(bf16_t, WS_O), WSP(float, CTL_RS)}; gemm_phase(lds, wave, p, S, E); }
        { Prob<256, 256, 4, 256 * 256, 0, SEQ * 256, 0, 256 * 256, 1024 * 256> p{WSP(bf16_t, WS_PM), WSP(bf16_t, WS_VMT)}; pg8::BatchOrder S; S.init(4, SEQ / 256, 4, G, bx);
          pg8::EpiMemPV E{WSP(float, CTL_RSM), WSP(bf16_t, WS_Z) + ZO_SGM, WSP(bf16_t, WS_MEMOUT)}; gemm_phase(lds, wave, p, S, E); }
    }
    GRID_BAR();

    {
        TIDS();
        const float* RS = WSP(float, CTL_RS); const bf16_t* Ob = WSP(bf16_t, WS_O); const bf16_t* Z = WSP(bf16_t, WS_Z); bf16_t* RetOut = WSP(bf16_t, WS_RETOUT);
        for (size_t i0 = gt; i0 < (size_t)SEQ * 1024; i0 += 4 * ngt) {
            u32x4 o[4], g[4]; float rs[4];
#pragma unroll
            for (int k = 0; k < 4; ++k) { const size_t i = i0 + k * ngt; if (i < (size_t)SEQ * 1024) { const int c8 = (int)(i & 1023), t = (int)(i >> 10);
                o[k] = *(const u32x4*)(Ob + (size_t)t * 8192 + c8 * 8); g[k] = *(const u32x4*)(Z + (size_t)t * LDZ + ZO_SGR + c8 * 8); rs[k] = RS[(size_t)(c8 >> 6) * SEQ + t]; } }
#pragma unroll
            for (int k = 0; k < 4; ++k) { const size_t i = i0 + k * ngt; if (i < (size_t)SEQ * 1024) { const int c8 = (int)(i & 1023), t = (int)(i >> 10);
                const float rstd = 1.0f / sqrtf(rs[k] * (1.0f / DV) + NORM_EPS);
                *(u32x4*)(RetOut + (size_t)t * 8192 + c8 * 8) = pack8(bf4_lo(o[k]) * rstd * bf4_lo(g[k]), bf4_hi(o[k]) * rstd * bf4_hi(g[k])); } }
        }
    }
    GRID_BAR();

    {
        { Prob<DM, DM, DM / 64, 256 * DM, 0, 0, 0, 256 * DM, 0> p{WSP(bf16_t, WS_POOLOUT), WSP(bf16_t, WS_WPP)}; pg8::StaticOrder S; S.init(SEQ / 256, DM / 256, G, bx);
          pg8::EpiProj<0> E{WSP(bf16_t, WS_Z) + ZO_AP, WSP(float, WS_MG), WSP(bf16_t, WS_MERGED)}; gemm_phase<BIG_ALIGN, BIG_SP2>(lds, wave, p, S, E); }
        { Prob<8192, 8192, 8192 / 64, 256 * 8192, 0, 0, 0, 256 * 8192, 0> p{WSP(bf16_t, WS_RETOUT), WSP(bf16_t, WS_WPR)}; pg8::StaticOrder S; S.init(SEQ / 256, DM / 256, G, bx);
          pg8::EpiProj<1> E{WSP(bf16_t, WS_Z) + ZO_AR, WSP(float, WS_MG), WSP(bf16_t, WS_MERGED)}; gemm_phase<BIG_ALIGN, BIG_SP2>(lds, wave, p, S, E); }
        { Prob<DM, DM, DM / 64, 256 * DM, 0, 0, 0, 256 * DM, 0> p{WSP(bf16_t, WS_MEMOUT), WSP(bf16_t, WS_WPM)}; pg8::StaticOrder S; S.init(SEQ / 256, DM / 256, G, bx);
          pg8::EpiProj<2> E{WSP(bf16_t, WS_Z) + ZO_AM, WSP(float, WS_MG), WSP(bf16_t, WS_MERGED)}; gemm_phase<BIG_ALIGN, BIG_SP2>(lds, wave, p, S, E); }
    }
    GRID_BAR();

    {
        Prob<DM, DM, DM / 64, 256 * DM, 0, 0, 0, 256 * DM, 0> p{WSP(bf16_t, WS_MERGED), WSP(bf16_t, WS_WO)}; pg8::StaticOrder S; S.init(SEQ / 256, DM / 256, G, bx);
        pg8::EpiOutProj E{args.in[0], args.out, WSP(float, CTL_RSO)}; gemm_phase<BIG_ALIGN, BIG_SP2>(lds, wave, p, S, E);
    }
    GRID_BAR();

    {
        TIDS();
        const bool bad = xb_ld(ctl + CW_BAR + XB_TMO) != 0u;
        const float* RSo = WSP(float, CTL_RSO); const float* norm_f = args.in[13]; float* out = args.out;
        const float qn = __builtin_nanf("");
        for (size_t i0 = gt; i0 < (size_t)SEQ * 1024; i0 += 4 * ngt) {
            f32x4 v[4], nf[4]; float rs[4];
#pragma unroll
            for (int k = 0; k < 4; ++k) { const size_t i = i0 + k * ngt; if (i < (size_t)SEQ * 1024) { const int c4 = (int)(i & 1023), t = (int)(i >> 10);
                v[k] = *(const f32x4*)(out + (size_t)t * DM + c4 * 4); nf[k] = *(const f32x4*)(norm_f + c4 * 4); rs[k] = RSo[t]; } }
#pragma unroll
            for (int k = 0; k < 4; ++k) { const size_t i = i0 + k * ngt; if (i < (size_t)SEQ * 1024) { const int c4 = (int)(i & 1023), t = (int)(i >> 10);
                const float rstd = 1.0f / sqrtf(rs[k] * (1.0f / DM) + NORM_EPS);
                f32x4 r = v[k] * rstd * nf[k]; if (bad) r = (f32x4){qn, qn, qn, qn};
                *(f32x4*)(out + (size_t)t * DM + c4 * 4) = r; } }
        }
    }
}

extern "C" void kernel_launch(void* const* d_in, const int* in_sizes, int n_in, void* d_out, int out_size, void* d_ws, size_t ws_size, hipStream_t stream) {
    static int grid = 0;
    if (grid == 0) {
        if (n_in != 14 || out_size != SEQ * DM || ws_size < WS_END) { fprintf(stderr, "kernel_launch: unexpected shapes (n_in %d, out %d, ws %zu < %zu); nothing launched\n", n_in, out_size, ws_size, (size_t)WS_END); grid = -1; return; }
        int dev = 0, cus = 0, per_cu = 0;
        if (hipGetDevice(&dev) != hipSuccess || hipDeviceGetAttribute(&cus, hipDeviceAttributeMultiprocessorCount, dev) != hipSuccess) { grid = -1; return; }
        if (hipFuncSetAttribute((const void*)fwd, hipFuncAttributeMaxDynamicSharedMemorySize, LDS_BYTES) != hipSuccess) { fprintf(stderr, "kernel_launch: hipFuncSetAttribute failed\n"); grid = -1; return; }
        if (hipOccupancyMaxActiveBlocksPerMultiprocessor(&per_cu, (const void*)fwd, NWAVES * 64, LDS_BYTES) != hipSuccess || per_cu < 1) fprintf(stderr, "kernel_launch: occupancy query reports %d\n", per_cu);
        (void)hipGetLastError();
        grid = cus;
    }
    if (grid < 0) return;
    (void)in_sizes;
    if (hipMemsetAsync((char*)d_ws + WS_CTL, 0, CTL_ZERO_BYTES, stream) != hipSuccess) return;
    Args a{};
    for (int i = 0; i < 14; ++i) a.in[i] = (const float*)d_in[i];
    a.out = (float*)d_out; a.ws = (unsigned char*)d_ws;
    hipLaunchKernelGGL(fwd, dim3(grid), dim3(NWAVES * 64), LDS_BYTES, stream, a);
}
```

```cpp
#include <hip/hip_runtime.h>
#include <cstdio>
#include <cstdint>
#ifndef BIG_ALIGN
#define BIG_ALIGN true
#endif
#ifndef BIG_SP2
#define BIG_SP2 true
#endif

#define LAS __attribute__((address_space(3)))
#define GAS __attribute__((address_space(1)))
typedef unsigned short bf16_t;
typedef short bf16x8 __attribute__((ext_vector_type(8)));
typedef float f32x4 __attribute__((ext_vector_type(4)));
typedef float f32x2 __attribute__((ext_vector_type(2)));
typedef unsigned u32x4 __attribute__((ext_vector_type(4)));
typedef unsigned u32x2 __attribute__((ext_vector_type(2)));

constexpr int SEQ = 8192, DM = 4096, MEML = 256, LDZ = 45056;
constexpr int NH = 16, DK = 256, DV = 512, CH = 256, NCH = SEQ / CH;
constexpr int ZO_U = 0, ZO_SGP = 4096, ZO_Q = 8192, ZO_K = 12288, ZO_SGR = 16384, ZO_QM = 24576, ZO_SGM = 28672, ZO_AP = 32768, ZO_AR = 36864, ZO_AM = 40960;
constexpr float NORM_EPS = 1e-6f;
constexpr int NWAVES = 8;

__device__ const float c_lg2g[16] = {
    -4.580368961e-02f, -2.272007650e-02f, -1.131531323e-02f, -5.646563141e-03f, -2.820519062e-03f, -1.409570255e-03f, -7.046129766e-04f, -3.522634716e-04f,
    -1.761209843e-04f, -8.805780458e-05f, -4.402823044e-05f, -2.201394726e-05f, -1.100693164e-05f, -5.503455325e-06f, -2.751725038e-06f, -1.375861863e-06f};
__device__ const float c_inv[128] = {
    1.000000000e+00f, 9.305720329e-01f, 8.659643531e-01f, 8.058421612e-01f, 7.498942018e-01f, 6.978305578e-01f, 6.493816376e-01f, 6.042963862e-01f, 5.623413324e-01f, 5.232990980e-01f, 4.869675338e-01f, 4.531583786e-01f, 4.216965139e-01f, 3.924189806e-01f, 3.651741147e-01f, 3.398208320e-01f,
    3.162277639e-01f, 2.942727208e-01f, 2.738419771e-01f, 2.548296750e-01f, 2.371373773e-01f, 2.206734121e-01f, 2.053525001e-01f, 1.910952926e-01f, 1.778279394e-01f, 1.654817164e-01f, 1.539926529e-01f, 1.433012635e-01f, 1.333521456e-01f, 1.240937784e-01f, 1.154781953e-01f, 1.074607819e-01f,
    1.000000015e-01f, 9.305720776e-02f, 8.659642935e-02f, 8.058422059e-02f, 7.498942316e-02f, 6.978306174e-02f, 6.493816525e-02f, 6.042964011e-02f, 5.623413250e-02f, 5.232991278e-02f, 4.869675264e-02f, 4.531583562e-02f, 4.216964915e-02f, 3.924189880e-02f, 3.651741147e-02f, 3.398208320e-02f,
    3.162277490e-02f, 2.942727134e-02f, 2.738419548e-02f, 2.548296750e-02f, 2.371373773e-02f, 2.206734009e-02f, 2.053525113e-02f, 1.910953037e-02f, 1.778279431e-02f, 1.654817164e-02f, 1.539926510e-02f, 1.433012541e-02f, 1.333521400e-02f, 1.240937784e-02f, 1.154781971e-02f, 1.074607857e-02f,
    9.999999776e-03f, 9.305720218e-03f, 8.659643121e-03f, 8.058422245e-03f, 7.498942316e-03f, 6.978305988e-03f, 6.493816152e-03f, 6.042963825e-03f, 5.623413250e-03f, 5.232991185e-03f, 4.869675264e-03f, 4.531583749e-03f, 4.216964822e-03f, 3.924189601e-03f, 3.651741194e-03f, 3.398208413e-03f,
    3.162277630e-03f, 2.942727180e-03f, 2.738419687e-03f, 2.548296703e-03f, 2.371373819e-03f, 2.206734149e-03f, 2.053525066e-03f, 1.910952968e-03f, 1.778279431e-03f, 1.654817141e-03f, 1.539926510e-03f, 1.433012541e-03f, 1.333521446e-03f, 1.240937738e-03f, 1.154782018e-03f, 1.074607833e-03f,
    1.000000047e-03f, 9.305720450e-04f, 8.659643354e-04f, 8.058421663e-04f, 7.498941850e-04f, 6.978305755e-04f, 6.493816036e-04f, 6.042963942e-04f, 5.623413017e-04f, 5.232990952e-04f, 4.869675322e-04f, 4.531583691e-04f, 4.216965172e-04f, 3.924189659e-04f, 3.651741135e-04f, 3.398208355e-04f,
    3.162277571e-04f, 2.942727297e-04f, 2.738419571e-04f, 2.548296761e-04f, 2.371373703e-04f, 2.206734061e-04f, 2.053525095e-04f, 1.910952997e-04f, 1.778279402e-04f, 1.654817170e-04f, 1.539926598e-04f, 1.433012512e-04f, 1.333521504e-04f, 1.240937709e-04f, 1.154782003e-04f, 1.074607862e-04f};

constexpr size_t MiB = 1u << 20;
constexpr size_t WS_CTL = 0, CTL_ZERO_BYTES = 4 * MiB;
constexpr int CW_BAR = 4096;
constexpr size_t CTL_RS = 1 * MiB;
constexpr size_t CTL_RSM = 1 * MiB + 512 * 1024;
constexpr size_t CTL_RSO = 1 * MiB + 768 * 1024;
constexpr size_t WS_WTA = CTL_ZERO_BYTES;
constexpr size_t WS_WTV = WS_WTA + (size_t)LDZ * DM * 2;
constexpr size_t WS_WG = WS_WTV + (size_t)8192 * DM * 2;
constexpr size_t WS_WK = WS_WG + (size_t)4 * 1024 * 1024 * 2;
constexpr size_t WS_WV = WS_WK + (size_t)DM * DM * 2;
constexpr size_t WS_WPP = WS_WV + (size_t)DM * DM * 2;
constexpr size_t WS_WPR = WS_WPP + (size_t)DM * DM * 2;
constexpr size_t WS_WPM = WS_WPR + (size_t)DM * 8192 * 2;
constexpr size_t WS_WO = WS_WPM + (size_t)DM * DM * 2;
constexpr size_t WS_H = WS_WO + (size_t)DM * DM * 2;
constexpr size_t WS_MEMN = WS_H + (size_t)SEQ * DM * 2;
constexpr size_t WS_ROPE = WS_MEMN + (size_t)MEML * DM * 2;
constexpr size_t WS_Z = WS_ROPE + (size_t)2 * SEQ * 128 * 4;
constexpr size_t WS_VS = WS_Z + (size_t)SEQ * LDZ * 2;
constexpr size_t WS_PQ = WS_VS + (size_t)NH * NCH * 512 * 512 * 2;
constexpr size_t WS_KDT = WS_PQ + (size_t)NH * SEQ * 512 * 2;
constexpr size_t WS_KVT = WS_KDT + (size_t)NH * NCH * 256 * 256 * 2;
constexpr size_t WS_O = WS_KVT + (size_t)NH * NCH * 512 * 256 * 2;
constexpr size_t WS_RETOUT = WS_O + (size_t)SEQ * 8192 * 2;
constexpr size_t WS_MIXED = WS_RETOUT + (size_t)SEQ * 8192 * 2;
constexpr size_t WS_POOLOUT = WS_MIXED + (size_t)SEQ * DM * 2;
constexpr size_t WS_MEMOUT = WS_POOLOUT + (size_t)SEQ * DM * 2;
constexpr size_t WS_KM = WS_MEMOUT + (size_t)SEQ * DM * 2;
constexpr size_t WS_VMT = WS_KM + (size_t)MEML * DM * 2;
constexpr size_t WS_PM = WS_VMT + (size_t)MEML * DM * 2;
constexpr size_t WS_MG = WS_PM + (size_t)4 * SEQ * 256 * 2;
constexpr size_t WS_MERGED = WS_MG + (size_t)SEQ * DM * 4;
constexpr size_t WS_KMP = WS_MERGED + (size_t)SEQ * DM * 2;
constexpr size_t WS_VMTP = WS_KMP + (size_t)8 * MEML * DM * 4;
constexpr size_t WS_END = WS_VMTP + (size_t)8 * MEML * DM * 4;

constexpr int RING_BYTES = 131072;
constexpr int TR_TILE_BYTES = 64 * 65 * 4;
constexpr int LDSCTL_OFF = 8 * TR_TILE_BYTES, MISC_OFF = LDSCTL_OFF + 320;
static_assert(LDSCTL_OFF >= RING_BYTES, "LDS map");
constexpr int LDS_BYTES = 147456;

__device__ __forceinline__ unsigned cvt_pk_bf16(float lo, float hi) { unsigned r; asm volatile("v_cvt_pk_bf16_f32 %0, %1, %2" : "=v"(r) : "v"(lo), "v"(hi)); return r; }
__device__ __forceinline__ float bf_lo(unsigned w) { return __uint_as_float(w << 16); }
__device__ __forceinline__ float bf_hi(unsigned w) { return __uint_as_float(w & 0xffff0000u); }
__device__ __forceinline__ f32x4 bf4_lo(u32x4 g) { return (f32x4){bf_lo(g.x), bf_hi(g.x), bf_lo(g.y), bf_hi(g.y)}; }
__device__ __forceinline__ f32x4 bf4_hi(u32x4 g) { return (f32x4){bf_lo(g.z), bf_hi(g.z), bf_lo(g.w), bf_hi(g.w)}; }
__device__ __forceinline__ u32x4 pack8(f32x4 a, f32x4 b) { u32x4 w; w.x = cvt_pk_bf16(a[0], a[1]); w.y = cvt_pk_bf16(a[2], a[3]); w.z = cvt_pk_bf16(b[0], b[1]); w.w = cvt_pk_bf16(b[2], b[3]); return w; }
__device__ __forceinline__ float sigm(float x) { return __builtin_amdgcn_rcpf(1.0f + __builtin_amdgcn_exp2f(-1.44269504f * x)); }
__device__ __forceinline__ void atomic_addf(float* p, float v) { (void)__hip_atomic_fetch_add(p, v, __ATOMIC_RELAXED, __HIP_MEMORY_SCOPE_AGENT); }
__device__ __forceinline__ int lane_id() { int l = (int)__builtin_amdgcn_mbcnt_hi(~0u, __builtin_amdgcn_mbcnt_lo(~0u, 0u)); asm volatile("" : "+v"(l)); return l; }
__device__ __forceinline__ float shx(float v, int lane, int mask) { return __int_as_float(__builtin_amdgcn_ds_bpermute((lane ^ mask) << 2, __float_as_int(v))); }
__device__ __forceinline__ float wave_sum(float v, int lane) {
#pragma unroll
    for (int o = 1; o < 64; o <<= 1) v += shx(v, lane, o);
    return v;
}

namespace pg8 {
constexpr int BM = 256, BK = 64, HALF = 128, HTB = HALF * BK * 2, STAGE_BYTES = 8 * HTB, NXCD = 8, WGM = 8;
__host__ __device__ __forceinline__ int lds_byte(int r, int c) { const int st = (r >> 4) * 2 + (c >> 5), rr = r & 15, cc = c & 31, ob = rr * 64 + cc * 2; return st * 1024 + (ob ^ (((ob >> 9) & 1) << 5)); }
__host__ __device__ __forceinline__ void stage_rc(int b, int& R, int& C) { const int st = b / 1024, sb = b % 1024, swz = sb ^ (((sb >> 9) & 1) << 5); R = (st >> 1) * 16 + swz / 64; C = (st & 1) * 32 + (swz % 64) / 2; }
__host__ __device__ __forceinline__ int perm32(int rho) { const int n = rho >> 4, i = rho & 15; return 8 * (i >> 2) + 4 * n + (i & 3); }

struct Unit { int pm, pn, b; };

struct StaticOrder {
    int nM, nN, nwg, G, c, wgm;
    __device__ void init(int nM_, int nN_, int G_, int c_, int wgm_ = 8) { nM = nM_; nN = nN_; nwg = nM * nN; G = G_; c = c_; wgm = wgm_; }
    __device__ bool next(int i, Unit& u) const {
        const long L = (long)i * G + c; if (L >= nwg) return false;
        int wgid = (int)L; { const int q = nwg / NXCD, r = nwg % NXCD, xcd = wgid % NXCD, off = wgid / NXCD; wgid = (xcd < r ? xcd * (q + 1) : r * (q + 1) + (xcd - r) * q) + off; }
        const int nig = wgm * nN, gid = wgid / nig, fm = gid * wgm, gsz = (nM - fm) < wgm ? (nM - fm) : wgm;
        u.pm = fm + ((wgid % nig) % gsz); u.pn = (wgid % nig) / gsz; u.b = 0; return true;
    }
    __device__ __forceinline__ void a_ready(const Unit&) const {}
    __device__ __forceinline__ void done(const Unit&) const {}
};
struct BatchOrder {
    int nM, nN, total, G, c;
    __device__ void init(int nb, int nM_, int nN_, int G_, int c_) { nM = nM_; nN = nN_; total = nb * nM * nN; G = G_; c = c_; }
    __device__ bool next(int i, Unit& u) const {
        const int L = i * G + c; if (L >= total) return false;
        u.pn = L % nN; const int t = L / nN; u.pm = t % nM; u.b = t / nM; return true;
    }
    __device__ __forceinline__ void a_ready(const Unit&) const {}
    __device__ __forceinline__ void done(const Unit&) const {}
};
template <int LDA, int LDB, int NT, int A_PM, int A_PN, int A_B, int B_PM, int B_PN, int B_B>
struct Prob {
    const bf16_t* A; const bf16_t* B;
    static constexpr int lda = LDA, ldb = LDB, nt = NT;
    __device__ __forceinline__ const char* a_base(const Unit& u) const { return (const char*)(A + (u.pm * A_PM + u.pn * A_PN + u.b * A_B)); }
    __device__ __forceinline__ const char* b_base(const Unit& u) const { return (const char*)(B + (u.pm * B_PM + u.pn * B_PN + u.b * B_B)); }
};

template <bool ALIGN_EPI = true, bool SP2 = true, class ProbT, class Epi, class Sched>
__device__ __forceinline__ void gemm_phase(LAS unsigned char* lds, const int wid, const ProbT P, const Sched& S, const Epi& E) {
    const int lane = lane_id(), tid = wid * 64 + lane, wr = wid >> 2, wc = wid & 3, fr = lane & 15, fq = lane >> 4;
    constexpr int nt = ProbT::nt;
    unsigned voffA[2], voffB[2];
#pragma unroll
    for (int i = 0; i < 2; ++i) { int R, C; stage_rc(tid * 16 + i * 8192, R, C); const int Rb = Epi::PERM ? ((R & ~31) + perm32(R & 31)) : R;
        voffA[i] = (unsigned)(R * ProbT::lda + C) * 2u; voffB[i] = (unsigned)(Rb * ProbT::ldb + C) * 2u; }
    const size_t kstep = (size_t)(BK * 2);
    constexpr size_t hstepA = (size_t)HALF * ProbT::lda * 2, hstepB = (size_t)HALF * ProbT::ldb * 2;
    const unsigned ldsw = (unsigned)wid * 1024u;
    const int aoff = lds_byte(wr * 64 + fr, fq * 8), boff = lds_byte(wc * 32 + fr, fq * 8);
#define PG8_SA(b, h) (((b) * 2 + (h)) * HTB)
#define PG8_SB(b, h) ((4 + (b) * 2 + (h)) * HTB)
#define PG8_STAGE(bufoff, gbase, voff) do { _Pragma("unroll") for (int _i = 0; _i < 2; ++_i) \
        __builtin_amdgcn_global_load_lds((const unsigned*)((const char*)(gbase) + (voff)[_i]), (LAS unsigned*)(lds + (bufoff) + ldsw + _i * 8192), 16, 0, 0); } while (0)
#define PG8_LDA(dst, b, h) do { _Pragma("unroll") for (int m = 0; m < 4; ++m) _Pragma("unroll") for (int k = 0; k < 2; ++k) dst[m][k] = *(const LAS bf16x8*)(lds + PG8_SA(b, h) + aoff + m * 2048 + k * 1024); } while (0)
#define PG8_LDB(dst, b, h) do { _Pragma("unroll") for (int n = 0; n < 2; ++n) _Pragma("unroll") for (int k = 0; k < 2; ++k) dst[n][k] = *(const LAS bf16x8*)(lds + PG8_SB(b, h) + boff + n * 2048 + k * 1024); } while (0)
#define PG8_MMA(ai, bj, At, Bt) do { __builtin_amdgcn_s_setprio(1); _Pragma("unroll") for (int m = 0; m < 4; ++m) _Pragma("unroll") for (int n = 0; n < 2; ++n) _Pragma("unroll") for (int k = 0; k < 2; ++k) \
        acc[ai][bj][m][n] = __builtin_amdgcn_mfma_f32_16x16x32_bf16(Bt[n][k], At[m][k], acc[ai][bj][m][n], 0, 0, 0); __builtin_amdgcn_s_setprio(0); } while (0)
#define PG8_WAIT_V(n) asm volatile("s_waitcnt vmcnt(" #n ")" ::: "memory")
#define PG8_WAIT_L(n) asm volatile("s_waitcnt lgkmcnt(" #n ")" ::: "memory")
#define PG8_BAR __builtin_amdgcn_s_barrier()
#define PG8_SCHED __builtin_amdgcn_sched_barrier(0)
    Unit cur, nxt; int ui = 0;
    if (!S.next(0, cur)) return;
    f32x4 acc[2][2][4][2];
#pragma unroll
    for (int a = 0; a < 2; ++a)
#pragma unroll
        for (int b = 0; b < 2; ++b)
#pragma unroll
            for (int m = 0; m < 4; ++m)
#pragma unroll
                for (int n = 0; n < 2; ++n) acc[a][b][m][n] = (f32x4){0.f, 0.f, 0.f, 0.f};
    bf16x8 At[4][2], B0[2][2], B1[2][2];
    const char* cA = P.a_base(cur); const char* cB = P.b_base(cur);
    S.a_ready(cur);
    if constexpr (SP2) {
    PG8_STAGE(PG8_SB(0, 0), cB, voffB); PG8_STAGE(PG8_SB(0, 1), cB + hstepB, voffB); PG8_STAGE(PG8_SA(0, 0), cA, voffA); PG8_STAGE(PG8_SA(0, 1), cA + hstepA, voffA);
    if (wr == 1) PG8_BAR;
    PG8_WAIT_V(2); PG8_BAR;
    PG8_STAGE(PG8_SB(1, 0), cB + kstep, voffB); PG8_STAGE(PG8_SA(1, 0), cA + kstep, voffA); PG8_STAGE(PG8_SB(1, 1), cB + hstepB + kstep, voffB);
    PG8_WAIT_V(6); PG8_BAR;
    } else {
    PG8_STAGE(PG8_SB(0, 0), cB, voffB); PG8_STAGE(PG8_SA(0, 0), cA, voffA); PG8_STAGE(PG8_SB(0, 1), cB + hstepB, voffB); PG8_STAGE(PG8_SA(0, 1), cA + hstepA, voffA);
    if (wr == 1) PG8_BAR;
    PG8_WAIT_V(4); PG8_BAR;
    PG8_STAGE(PG8_SB(1, 0), cB + kstep, voffB); PG8_STAGE(PG8_SA(1, 0), cA + kstep, voffA); PG8_STAGE(PG8_SB(1, 1), cB + hstepB + kstep, voffB);
    PG8_WAIT_V(6); PG8_BAR;
    }
    for (;;) {
        const bool has_next = S.next(ui + 1, nxt);
        const char* nA = has_next ? P.a_base(nxt) : cA; const char* nB = has_next ? P.b_base(nxt) : cB;
        for (int t = 0; t < nt; t += 2) {
            const bool last = (t == nt - 2);
            const char* a1 = cA + (size_t)(t + 1) * kstep;
            const char* a2 = last ? nA : cA + (size_t)(t + 2) * kstep; const char* b2 = last ? nB : cB + (size_t)(t + 2) * kstep;
            const char* a3 = a2 + kstep; const char* b3 = b2 + kstep;
            if (last && has_next) S.a_ready(nxt);
            if constexpr (SP2) {
            PG8_LDB(B0, 0, 0); PG8_LDB(B1, 0, 1); PG8_SCHED; PG8_LDA(At, 0, 0); PG8_STAGE(PG8_SA(1, 1), a1 + hstepA, voffA);
            PG8_WAIT_V(8); PG8_WAIT_L(0); PG8_BAR; PG8_MMA(0, 0, At, B0); PG8_MMA(0, 1, At, B1); PG8_BAR; PG8_SCHED;
            PG8_LDA(At, 0, 1); PG8_STAGE(PG8_SB(0, 0), b2, voffB); PG8_STAGE(PG8_SB(0, 1), b2 + hstepB, voffB); PG8_STAGE(PG8_SA(0, 0), a2, voffA);
            PG8_WAIT_V(8); PG8_WAIT_L(0); PG8_BAR; PG8_MMA(1, 0, At, B0); PG8_MMA(1, 1, At, B1); PG8_BAR; PG8_SCHED;
            PG8_LDB(B0, 1, 0); PG8_LDB(B1, 1, 1); PG8_SCHED; PG8_LDA(At, 1, 0); PG8_STAGE(PG8_SA(0, 1), a2 + hstepA, voffA);
            PG8_WAIT_V(8); PG8_WAIT_L(0); PG8_BAR; PG8_MMA(0, 0, At, B0); PG8_MMA(0, 1, At, B1); PG8_BAR; PG8_SCHED;
            PG8_LDA(At, 1, 1); PG8_STAGE(PG8_SB(1, 0), b3, voffB); PG8_STAGE(PG8_SB(1, 1), b3 + hstepB, voffB); PG8_STAGE(PG8_SA(1, 0), a3, voffA);
            PG8_WAIT_V(8); PG8_WAIT_L(0); PG8_BAR; PG8_MMA(1, 0, At, B0); PG8_MMA(1, 1, At, B1); PG8_BAR; PG8_SCHED;
            } else {
            PG8_LDB(B0, 0, 0); PG8_SCHED; PG8_LDA(At, 0, 0); PG8_STAGE(PG8_SA(1, 1), a1 + hstepA, voffA);
            PG8_WAIT_L(8); PG8_BAR; PG8_WAIT_L(0); PG8_MMA(0, 0, At, B0); PG8_BAR; PG8_SCHED;
            PG8_LDB(B1, 0, 1); PG8_STAGE(PG8_SB(0, 0), b2, voffB);
            PG8_BAR; PG8_WAIT_L(0); PG8_MMA(0, 1, At, B1); PG8_BAR;
            PG8_LDA(At, 0, 1); PG8_STAGE(PG8_SA(0, 0), a2, voffA);
            PG8_BAR; PG8_WAIT_L(0); PG8_MMA(1, 0, At, B0); PG8_BAR; PG8_SCHED;
            PG8_STAGE(PG8_SB(0, 1), b2 + hstepB, voffB);
            PG8_WAIT_V(6); PG8_BAR; PG8_MMA(1, 1, At, B1); PG8_BAR;
            PG8_LDB(B0, 1, 0); PG8_SCHED; PG8_LDA(At, 1, 0); PG8_STAGE(PG8_SA(0, 1), a2 + hstepA, voffA);
            PG8_WAIT_L(8); PG8_BAR; PG8_WAIT_L(0); PG8_MMA(0, 0, At, B0); PG8_BAR; PG8_SCHED;
            PG8_LDB(B1, 1, 1); PG8_STAGE(PG8_SB(1, 0), b3, voffB);
            PG8_BAR; PG8_WAIT_L(0); PG8_MMA(0, 1, At, B1); PG8_BAR;
            PG8_LDA(At, 1, 1); PG8_STAGE(PG8_SA(1, 0), a3, voffA);
            PG8_BAR; PG8_WAIT_L(0); PG8_MMA(1, 0, At, B0); PG8_BAR; PG8_SCHED;
            PG8_STAGE(PG8_SB(1, 1), b3 + hstepB, voffB);
            PG8_WAIT_V(6); PG8_BAR; PG8_MMA(1, 1, At, B1); PG8_BAR;
            }
        }
        if constexpr (ALIGN_EPI) { if (wr == 0) PG8_BAR; }
        E(acc, cur, wr, wc); S.done(cur);
        if (!has_next) break;
#pragma unroll
        for (int a = 0; a < 2; ++a)
#pragma unroll
            for (int b = 0; b < 2; ++b)
#pragma unroll
                for (int m = 0; m < 4; ++m)
#pragma unroll
                    for (int n = 0; n < 2; ++n) acc[a][b][m][n] = (f32x4){0.f, 0.f, 0.f, 0.f};
        cur = nxt; cA = nA; cB = nB; ++ui;
        if constexpr (ALIGN_EPI) { if (wr == 1) PG8_BAR; }
    }
    PG8_WAIT_V(0);
    if constexpr (!ALIGN_EPI) { if (wr == 0) PG8_BAR; }
    PG8_BAR;
#undef PG8_SA
#undef PG8_SB
#undef PG8_STAGE
#undef PG8_LDA
#undef PG8_LDB
#undef PG8_MMA
#undef PG8_WAIT_V
#undef PG8_WAIT_L
#undef PG8_BAR
#undef PG8_SCHED
}

typedef const f32x4 (&AccRef)[2][2][4][2];
#define ROWG(ai, m) ({ int _r = (ai) * 128 + (m) * 16; asm volatile("" : "+v"(_r)); _r; })

struct EpiPlain {
    static constexpr bool PERM = true;
    bf16_t* O; int ldc, sb, spm, spn;
    __device__ __forceinline__ void operator()(AccRef acc, const Unit& u, int wr, int wc) const {
        const int lane_ = lane_id(), fr = lane_ & 15, fq = lane_ >> 4;
        bf16_t* base = O + (u.b * sb + u.pm * spm + u.pn * spn) + (wr * 64 + fr) * ldc + wc * 32 + fq * 8;
#pragma unroll
        for (int ai = 0; ai < 2; ++ai)
#pragma unroll
            for (int m = 0; m < 4; ++m)
#pragma unroll
                for (int bj = 0; bj < 2; ++bj) *(u32x4*)(base + (size_t)(ai * 128 + m * 16) * ldc + bj * 128) = pack8(acc[ai][bj][m][0], acc[ai][bj][m][1]);
    }
};

struct EpiF32Slab {
    static constexpr bool PERM = false;
    float* O; int ldc, sb, spm, spn;
    __device__ __forceinline__ void operator()(AccRef acc, const Unit& u, int wr, int wc) const {
        const int lane_ = lane_id(), fr = lane_ & 15, fq = lane_ >> 4;
        float* base = O + (u.b * sb + u.pm * spm + u.pn * spn) + (wr * 64 + fr) * ldc + wc * 32 + fq * 4;
#pragma unroll
        for (int ai = 0; ai < 2; ++ai)
#pragma unroll
            for (int m = 0; m < 4; ++m)
#pragma unroll
                for (int bj = 0; bj < 2; ++bj)
#pragma unroll
                    for (int n = 0; n < 2; ++n) *(f32x4*)(base + (size_t)(ai * 128 + m * 16) * ldc + bj * 128 + n * 16) = acc[ai][bj][m][n];
    }
};

struct EpiMain {
    static constexpr bool PERM = true;
    bf16_t* Z; bf16_t* PQ; bf16_t* KdT; const float* ropec; const float* ropes;
    __device__ __forceinline__ void operator()(AccRef acc, const Unit& u, int wr, int wc) const {
        const int lane_ = lane_id(), fr = lane_ & 15, fq = lane_ >> 4;
        const int pn = u.pn, lr0 = wr * 64 + fr, lc = wc * 32 + fq * 8;
        bf16_t* zb = Z + (size_t)(u.pm * 256 + lr0) * LDZ + pn * 256 + lc;
        if (pn >= 32 && pn < 64) {
            const bool isk = pn >= 48; const int head = (pn - 32) & 15; const float lg = c_lg2g[head];
#pragma unroll
            for (int ai = 0; ai < 2; ++ai)
#pragma unroll
                for (int m = 0; m < 4; ++m) {
                    const int rg = ROWG(ai, m), il = lr0 + rg, row = u.pm * 256 + il;
                    const f32x4 c0 = *(const f32x4*)(ropec + (size_t)row * 128 + lc), c1 = *(const f32x4*)(ropec + (size_t)row * 128 + lc + 4);
                    const f32x4 s0 = *(const f32x4*)(ropes + (size_t)row * 128 + lc), s1 = *(const f32x4*)(ropes + (size_t)row * 128 + lc + 4);
                    const f32x4 x10 = acc[ai][0][m][0], x11 = acc[ai][0][m][1], x20 = acc[ai][1][m][0], x21 = acc[ai][1][m][1];
                    const f32x4 y10 = x10 * c0 - x20 * s0, y11 = x11 * c1 - x21 * s1, y20 = x20 * c0 + x10 * s0, y21 = x21 * c1 + x11 * s1;
                    bf16_t* zr = zb + (size_t)rg * LDZ;
                    *(u32x4*)zr = pack8(y10, y11); *(u32x4*)(zr + 128) = pack8(y20, y21);
                    if (!isk) {
                        const float dq = __builtin_amdgcn_exp2f((float)(il + 1) * lg);
                        bf16_t* pq = PQ + ((size_t)head * SEQ + row) * 512 + 256 + lc;
                        *(u32x4*)pq = pack8(y10 * dq, y11 * dq); *(u32x4*)(pq + 128) = pack8(y20 * dq, y21 * dq);
                    } else {
                        const float dk = __builtin_amdgcn_exp2f((float)(255 - il) * lg);
                        bf16_t* kt = KdT + ((size_t)(head * NCH + u.pm) * 256 + lc) * 256 + il;
                        const u32x4 w1 = pack8(y10 * dk, y11 * dk), w2 = pack8(y20 * dk, y21 * dk);
                        kt[0 * 256] = (bf16_t)(w1.x & 0xffffu); kt[1 * 256] = (bf16_t)(w1.x >> 16); kt[2 * 256] = (bf16_t)(w1.y & 0xffffu); kt[3 * 256] = (bf16_t)(w1.y >> 16);
                        kt[4 * 256] = (bf16_t)(w1.z & 0xffffu); kt[5 * 256] = (bf16_t)(w1.z >> 16); kt[6 * 256] = (bf16_t)(w1.w & 0xffffu); kt[7 * 256] = (bf16_t)(w1.w >> 16);
                        bf16_t* kt2 = kt + 128 * 256;
                        kt2[0 * 256] = (bf16_t)(w2.x & 0xffffu); kt2[1 * 256] = (bf16_t)(w2.x >> 16); kt2[2 * 256] = (bf16_t)(w2.y & 0xffffu); kt2[3 * 256] = (bf16_t)(w2.y >> 16);
                        kt2[4 * 256] = (bf16_t)(w2.z & 0xffffu); kt2[5 * 256] = (bf16_t)(w2.z >> 16); kt2[6 * 256] = (bf16_t)(w2.w & 0xffffu); kt2[7 * 256] = (bf16_t)(w2.w >> 16);
                    }
                    asm volatile("" ::: "memory");
                }
        } else {
            const int act = (pn < 16) ? 0 : (pn < 96) ? 1 : (pn < 112) ? 0 : (pn < 128) ? 1 : 2;
            if (act == 0) {
#pragma unroll
                for (int ai = 0; ai < 2; ++ai)
#pragma unroll
                    for (int m = 0; m < 4; ++m) { const int rg = ROWG(ai, m);
#pragma unroll
                        for (int bj = 0; bj < 2; ++bj) *(u32x4*)(zb + (size_t)rg * LDZ + bj * 128) = pack8(acc[ai][bj][m][0], acc[ai][bj][m][1]); }
            } else {
                const bool is_silu = act == 1;
#pragma unroll
                for (int ai = 0; ai < 2; ++ai)
#pragma unroll
                    for (int m = 0; m < 4; ++m) { const int rg = ROWG(ai, m);
#pragma unroll
                        for (int bj = 0; bj < 2; ++bj) { f32x4 v0 = acc[ai][bj][m][0], v1 = acc[ai][bj][m][1];
#pragma unroll
                            for (int e = 0; e < 4; ++e) { const float s0 = sigm(v0[e]), s1 = sigm(v1[e]); v0[e] = is_silu ? v0[e] * s0 : s0; v1[e] = is_silu ? v1[e] * s1 : s1; }
                            *(u32x4*)(zb + (size_t)rg * LDZ + bj * 128) = pack8(v0, v1); }
                        asm volatile("" ::: "memory"); }
            }
        }
    }
};

struct EpiVt {
    static constexpr bool PERM = true;
    bf16_t* VS;
    __device__ __forceinline__ void operator()(AccRef acc, const Unit& u, int wr, int wc) const {
        const int lane_ = lane_id(), fr = lane_ & 15, fq = lane_ >> 4;
        bf16_t* base = VS + ((size_t)((u.pm >> 1) * NCH + u.pn) * 512 + (u.pm & 1) * 256 + wr * 64 + fr) * 512 + wc * 32 + fq * 8;
#pragma unroll
        for (int ai = 0; ai < 2; ++ai)
#pragma unroll
            for (int m = 0; m < 4; ++m)
#pragma unroll
                for (int bj = 0; bj < 2; ++bj) *(u32x4*)(base + (size_t)(ai * 128 + m * 16) * 512 + bj * 128) = pack8(acc[ai][bj][m][0], acc[ai][bj][m][1]);
    }
};

struct EpiScores {
    static constexpr bool PERM = true;
    bf16_t* PQ;
    __device__ __forceinline__ void operator()(AccRef acc, const Unit& u, int wr, int wc) const {
        const int lane_ = lane_id(), fr = lane_ & 15, fq = lane_ >> 4;
        const float lg = c_lg2g[u.b]; const int lr0 = wr * 64 + fr, lc = wc * 32 + fq * 8;
        bf16_t* base = PQ + ((size_t)u.b * SEQ + u.pm * 256 + lr0) * 512 + lc;
        float gp[8];
#pragma unroll
        for (int e = 0; e < 8; ++e) gp[e] = __builtin_amdgcn_exp2f((float)(7 - e) * lg);
#pragma unroll
        for (int ai = 0; ai < 2; ++ai)
#pragma unroll
            for (int m = 0; m < 4; ++m) { const int rg = ROWG(ai, m);
#pragma unroll
                for (int bj = 0; bj < 2; ++bj) {
                    const int dd = (lr0 + rg) - (lc + bj * 128);
                    const float g0 = __builtin_amdgcn_exp2f((float)(dd - 7) * lg);
                    f32x4 v0 = acc[ai][bj][m][0], v1 = acc[ai][bj][m][1];
#pragma unroll
                    for (int e = 0; e < 4; ++e) { v0[e] = (dd - e) >= 0 ? v0[e] * (g0 * gp[e]) : 0.f; v1[e] = (dd - 4 - e) >= 0 ? v1[e] * (g0 * gp[4 + e]) : 0.f; }
                    *(u32x4*)(base + (size_t)rg * 512 + bj * 128) = pack8(v0, v1);
                }
                asm volatile("" ::: "memory");
            }
    }
};

struct EpiRetOut {
    static constexpr bool PERM = true;
    bf16_t* O; float* RS;
    __device__ __forceinline__ void operator()(AccRef acc, const Unit& u, int wr, int wc) const {
        const int lane_ = lane_id(), fr = lane_ & 15, fq = lane_ >> 4;
        const int row0 = u.pm * 256 + wr * 64 + fr;
        bf16_t* base = O + (size_t)row0 * 8192 + u.b * 512 + u.pn * 256 + wc * 32 + fq * 8;
#pragma unroll
        for (int ai = 0; ai < 2; ++ai)
#pragma unroll
            for (int m = 0; m < 4; ++m) { const int rg = ROWG(ai, m);
                float s = 0.f;
#pragma unroll
                for (int bj = 0; bj < 2; ++bj) { const f32x4 v0 = acc[ai][bj][m][0], v1 = acc[ai][bj][m][1];
                    s += (v0[0] * v0[0] + v0[1] * v0[1]) + (v0[2] * v0[2] + v0[3] * v0[3]) + (v1[0] * v1[0] + v1[1] * v1[1]) + (v1[2] * v1[2] + v1[3] * v1[3]);
                    *(u32x4*)(base + (size_t)rg * 8192 + bj * 128) = pack8(v0, v1); }
                s += shx(s, lane_, 16); s += shx(s, lane_, 32);
                if (fq == 0) atomic_addf(RS + (size_t)u.b * SEQ + row0 + rg, s);
                asm volatile("" ::: "memory");
            }
    }
};

struct EpiMemS {
    static constexpr bool PERM = true;
    bf16_t* Pm; float* RSm;
    __device__ __forceinline__ void operator()(AccRef acc, const Unit& u, int wr, int wc) const {
        const int lane_ = lane_id(), fr = lane_ & 15, fq = lane_ >> 4;
        const int row0 = u.pm * 256 + wr * 64 + fr;
        bf16_t* base = Pm + ((size_t)u.b * SEQ + row0) * 256 + wc * 32 + fq * 8;
#pragma unroll
        for (int ai = 0; ai < 2; ++ai)
#pragma unroll
            for (int m = 0; m < 4; ++m) { const int rg = ROWG(ai, m);
                float s = 0.f;
#pragma unroll
                for (int bj = 0; bj < 2; ++bj) { f32x4 v0 = acc[ai][bj][m][0], v1 = acc[ai][bj][m][1];
#pragma unroll
                    for (int e = 0; e < 4; ++e) { v0[e] = __builtin_amdgcn_exp2f(fminf(v0[e], 80.f) * 1.44269504f); v1[e] = __builtin_amdgcn_exp2f(fminf(v1[e], 80.f) * 1.44269504f); }
                    const u32x4 w = pack8(v0, v1);
                    s += (bf_lo(w.x) + bf_hi(w.x)) + (bf_lo(w.y) + bf_hi(w.y)) + (bf_lo(w.z) + bf_hi(w.z)) + (bf_lo(w.w) + bf_hi(w.w));
                    *(u32x4*)(base + (size_t)rg * 256 + bj * 128) = w; }
                s += shx(s, lane_, 16); s += shx(s, lane_, 32);
                if (fq == 0) atomic_addf(RSm + (size_t)u.b * SEQ + row0 + rg, s);
                asm volatile("" ::: "memory");
            }
    }
};

struct EpiMemPV {
    static constexpr bool PERM = true;
    const float* RSm; const bf16_t* Zg; bf16_t* Out;
    __device__ __forceinline__ void operator()(AccRef acc, const Unit& u, int wr, int wc) const {
        const int lane_ = lane_id(), fr = lane_ & 15, fq = lane_ >> 4;
        const int row0 = u.pm * 256 + wr * 64 + fr, col0 = u.b * 1024 + u.pn * 256 + wc * 32 + fq * 8;
#pragma unroll
        for (int ai = 0; ai < 2; ++ai)
#pragma unroll
            for (int m = 0; m < 4; ++m) { const int row = row0 + ROWG(ai, m);
                const float rinv = 1.0f / RSm[(size_t)u.b * SEQ + row];
#pragma unroll
                for (int bj = 0; bj < 2; ++bj) { const u32x4 g = *(const u32x4*)(Zg + (size_t)row * LDZ + col0 + bj * 128);
                    *(u32x4*)(Out + (size_t)row * DM + col0 + bj * 128) = pack8(acc[ai][bj][m][0] * rinv * bf4_lo(g), acc[ai][bj][m][1] * rinv * bf4_hi(g)); }
                asm volatile("" ::: "memory"); }
    }
};

struct EpiPool {
    static constexpr bool PERM = true;
    const float* scale; const bf16_t* Zg; bf16_t* Out;
    __device__ __forceinline__ void operator()(AccRef acc, const Unit& u, int wr, int wc) const {
        const int lane_ = lane_id(), fr = lane_ & 15, fq = lane_ >> 4;
        const int row0 = u.pm * 256 + wr * 64 + fr, col0 = u.b * 1024 + u.pn * 256 + wc * 32 + fq * 8;
        f32x4 sc[2][2];
#pragma unroll
        for (int bj = 0; bj < 2; ++bj) { sc[bj][0] = *(const f32x4*)(scale + col0 + bj * 128); sc[bj][1] = *(const f32x4*)(scale + col0 + bj * 128 + 4); }
#pragma unroll
        for (int ai = 0; ai < 2; ++ai)
#pragma unroll
            for (int m = 0; m < 4; ++m) { const int row = row0 + ROWG(ai, m);
#pragma unroll
                for (int bj = 0; bj < 2; ++bj) { const u32x4 g = *(const u32x4*)(Zg + (size_t)row * LDZ + col0 + bj * 128);
                    *(u32x4*)(Out + (size_t)row * DM + col0 + bj * 128) = pack8(acc[ai][bj][m][0] * sc[bj][0] * bf4_lo(g), acc[ai][bj][m][1] * sc[bj][1] * bf4_hi(g)); }
                asm volatile("" ::: "memory"); }
    }
};

template <int STAGE> struct EpiProj {
    static constexpr bool PERM = true;
    const bf16_t* Zg; float* Mg; bf16_t* Merged;
    __device__ __forceinline__ void operator()(AccRef acc, const Unit& u, int wr, int wc) const {
        const int lane_ = lane_id(), fr = lane_ & 15, fq = lane_ >> 4;
        const int row0 = u.pm * 256 + wr * 64 + fr, col0 = u.pn * 256 + wc * 32 + fq * 8;
#pragma unroll
        for (int ai = 0; ai < 2; ++ai)
#pragma unroll
            for (int mp = 0; mp < 2; ++mp) {
                int row[2]; u32x4 g[2][2]; f32x4 p0[2][2], p1[2][2];
#pragma unroll
                for (int k = 0; k < 2; ++k) { row[k] = row0 + ROWG(ai, 2 * mp + k);
#pragma unroll
                    for (int bj = 0; bj < 2; ++bj) { g[k][bj] = *(const u32x4*)(Zg + (size_t)row[k] * LDZ + col0 + bj * 128);
                        if (STAGE > 0) { const float* mp_ = Mg + (size_t)row[k] * DM + col0 + bj * 128; p0[k][bj] = *(const f32x4*)mp_; p1[k][bj] = *(const f32x4*)(mp_ + 4); } } }
#pragma unroll
                for (int k = 0; k < 2; ++k)
#pragma unroll
                    for (int bj = 0; bj < 2; ++bj) { const int m = 2 * mp + k;
                        f32x4 v0 = acc[ai][bj][m][0] * bf4_lo(g[k][bj]), v1 = acc[ai][bj][m][1] * bf4_hi(g[k][bj]);
                        if (STAGE > 0) { v0 += p0[k][bj]; v1 += p1[k][bj]; }
                        float* mq = Mg + (size_t)row[k] * DM + col0 + bj * 128;
                        if (STAGE < 2) { *(f32x4*)mq = v0; *(f32x4*)(mq + 4) = v1; }
                        else *(u32x4*)(Merged + (size_t)row[k] * DM + col0 + bj * 128) = pack8(v0, v1); }
                asm volatile("" ::: "memory"); }
    }
};

struct EpiOutProj {
    static constexpr bool PERM = false;
    const float* x; float* out; float* RSo;
    __device__ __forceinline__ void operator()(AccRef acc, const Unit& u, int wr, int wc) const {
        const int lane_ = lane_id(), fr = lane_ & 15, fq = lane_ >> 4;
        const int row0 = u.pm * 256 + wr * 64 + fr, col0 = u.pn * 256 + wc * 32 + fq * 4;
#pragma unroll
        for (int ai = 0; ai < 2; ++ai)
#pragma unroll
            for (int m = 0; m < 4; ++m) { const int row = row0 + ROWG(ai, m); float s = 0.f;
#pragma unroll
                for (int bj = 0; bj < 2; ++bj)
#pragma unroll
                    for (int n = 0; n < 2; ++n) { const size_t off = (size_t)row * DM + col0 + bj * 128 + n * 16;
                        const f32x4 v = *(const f32x4*)(x + off) + acc[ai][bj][m][n]; *(f32x4*)(out + off) = v;
                        s += (v[0] * v[0] + v[1] * v[1]) + (v[2] * v[2] + v[3] * v[3]); }
                s += shx(s, lane_, 16); s += shx(s, lane_, 32);
                if (fq == 0) atomic_addf(RSo + row, s);
                asm volatile("" ::: "memory"); }
    }
};
}

#define XB_TMO      128
#define XB_XCNT(j)  (256  + 64 * (j))
#define XB_XSUB(j)  (1280 + 64 * (j))
#define XB_XGEN(j)  (2304 + 64 * (j))
#define XB_TOP      3328
#define XB_TOPGEN   3392
#define XCD_BAR_WORDS 3456
#define XB_SPIN_CAP (1u << 18)
__device__ __forceinline__ unsigned xb_ld(unsigned* p)              { return __hip_atomic_load(p, __ATOMIC_RELAXED, __HIP_MEMORY_SCOPE_AGENT); }
__device__ __forceinline__ unsigned xb_add(unsigned* p, unsigned v) { return __hip_atomic_fetch_add(p, v, __ATOMIC_RELAXED, __HIP_MEMORY_SCOPE_AGENT); }
__device__ __forceinline__ unsigned xb_xcc_id() { return (unsigned)__builtin_amdgcn_s_getreg((3 << 11) | 20) & 0xFu; }
#define XB_SPIN(cond, bar) do { unsigned _sp = 0; while (cond) { __builtin_amdgcn_s_sleep(1); \
    if ((++_sp & 255u) == 0u) { if (xb_ld(&(bar)[XB_TMO])) break; if (_sp > XB_SPIN_CAP) { atomicAdd(&(bar)[XB_TMO], 1u); break; } } } } while (0)
struct XcdBarrier { unsigned* bar; unsigned x; volatile LAS unsigned* st; };
__device__ __forceinline__ XcdBarrier xcd_barrier_post(unsigned* bar, volatile LAS unsigned* st, bool leader) {
    XcdBarrier b; b.bar = bar; b.x = xb_xcc_id(); b.st = st;
    if (leader) (void)xb_add(&bar[XB_XCNT(b.x)], 1u);
    return b;
}
__device__ __forceinline__ void xcd_barrier_complete(unsigned* bar, unsigned x, unsigned& nloc, unsigned& nx) {
    const unsigned G = gridDim.x * gridDim.y * gridDim.z;
    unsigned sum, cnt, mine, sp = 0u;
    for (;;) {
        sum = 0u; cnt = 0u; mine = 0u;
#pragma unroll
        for (unsigned j = 0; j < 16; ++j) { const unsigned c = xb_ld(&bar[XB_XCNT(j)]); sum += c; cnt += (c > 0u) ? 1u : 0u; mine = (j == x) ? c : mine; }
        if (sum == G) break;
        __builtin_amdgcn_s_sleep(1);
        if ((++sp & 255u) == 0u) { if (xb_ld(&bar[XB_TMO])) break; if (sp > XB_SPIN_CAP) { atomicAdd(&bar[XB_TMO], 1u); break; } }
    }
    nloc = mine > 0u ? mine : 1u; nx = cnt > 0u ? cnt : 1u;
}
__device__ __forceinline__ void xcd_barrier(const XcdBarrier& b, bool leader) {
    asm volatile("s_waitcnt vmcnt(0)" ::: "memory");
    __syncthreads();
    if (leader) {
        unsigned* bar = b.bar;
        __builtin_amdgcn_s_waitcnt(0);
        unsigned nloc = b.st[0], nx = b.st[1];
        if (nloc == 0u) { xcd_barrier_complete(bar, b.x, nloc, nx); b.st[0] = nloc; b.st[1] = nx; }
        const unsigned old = xb_add(&bar[XB_XSUB(b.x)], 1u);
        const unsigned gen = old / nloc;
        if (old + 1u == (gen + 1u) * nloc) {
            __builtin_amdgcn_fence(__ATOMIC_RELEASE, "agent");
            asm volatile("s_waitcnt vmcnt(0)" ::: "memory");
            const unsigned og = xb_add(&bar[XB_TOP], 1u);
            const unsigned tg = og / nx;
            if (og + 1u == (tg + 1u) * nx) xb_add(&bar[XB_TOPGEN], 1u);
            else XB_SPIN(xb_ld(&bar[XB_TOPGEN]) == tg, bar);
            __builtin_amdgcn_fence(__ATOMIC_ACQUIRE, "agent");
            xb_add(&bar[XB_XGEN(b.x)], 1u);
            asm volatile("s_waitcnt vmcnt(0)" ::: "memory");
        } else {
            XB_SPIN(xb_ld(&bar[XB_XGEN(b.x)]) == gen, bar);
            __builtin_amdgcn_fence(__ATOMIC_ACQUIRE, "agent");
            asm volatile("s_waitcnt vmcnt(0)" ::: "memory");
        }
    }
    __syncthreads();
}

#define LDS_WAIT() asm volatile("s_waitcnt lgkmcnt(0)" ::: "memory")
__device__ __forceinline__ void transpose_item(const float* W, int ldw, int col0, int k0, bf16_t* WT, int ldt, int row0, float scale, LAS float* scr, int lane) {
    const int kr = lane >> 4, n4 = (lane & 15) * 4;
    const float* src = W + (size_t)(k0 + kr) * ldw + col0 + n4;
    f32x4 v[16];
#pragma unroll
    for (int i = 0; i < 16; ++i) v[i] = __builtin_nontemporal_load((const f32x4*)(src + (size_t)(4 * i) * ldw));
#pragma unroll
    for (int i = 0; i < 16; ++i) { LAS float* d = scr + (4 * i + kr) * 65 + n4; d[0] = v[i][0]; d[1] = v[i][1]; d[2] = v[i][2]; d[3] = v[i][3]; }
    LDS_WAIT(); asm volatile("" ::: "memory");
    const int c = lane & 7, nl = lane >> 3;
#pragma unroll
    for (int j = 0; j < 8; ++j) { const int n = nl + 8 * j; const LAS float* q = scr + (8 * c) * 65 + n;
        u32x4 o; o.x = cvt_pk_bf16(q[0 * 65] * scale, q[1 * 65] * scale); o.y = cvt_pk_bf16(q[2 * 65] * scale, q[3 * 65] * scale); o.z = cvt_pk_bf16(q[4 * 65] * scale, q[5 * 65] * scale); o.w = cvt_pk_bf16(q[6 * 65] * scale, q[7 * 65] * scale);
        *(u32x4*)(WT + (size_t)(row0 + n) * ldt + k0 + 8 * c) = o; }
    LDS_WAIT(); asm volatile("" ::: "memory");
}
__device__ __forceinline__ void transpose_job(const float* W, int K, int ldw, int coff, int ncols, bf16_t* WT, int roff, float scale, LAS float* scr, int lane, int gw, int ngw) {
    const int nblk = ncols / 64, items = (K / 64) * nblk;
    for (int it = gw; it < items; it += ngw) { const int kb = it / nblk, nb = it % nblk;
        transpose_item(W, ldw, coff + 64 * nb, 64 * kb, WT, K, roff + 64 * nb, scale, scr, lane); }
}
__device__ __forceinline__ void rms_row_to_bf16(const float* xrow, const float* g, bf16_t* orow, int lane) {
    const f32x4* xr = (const f32x4*)xrow + lane; const f32x4* gr = (const f32x4*)g + lane;
    f32x4 v[16]; float s = 0.f;
#pragma unroll
    for (int j = 0; j < 16; ++j) { v[j] = xr[64 * j]; s += (v[j][0] * v[j][0] + v[j][1] * v[j][1]) + (v[j][2] * v[j][2] + v[j][3] * v[j][3]); }
    const float rstd = 1.0f / sqrtf(wave_sum(s, lane) * (1.0f / DM) + NORM_EPS);
    u32x2* o8 = (u32x2*)orow + lane;
#pragma unroll
    for (int j = 0; j < 16; ++j) { const f32x4 gg = gr[64 * j]; u32x2 w; w.x = cvt_pk_bf16(v[j][0] * rstd * gg[0], v[j][1] * rstd * gg[1]); w.y = cvt_pk_bf16(v[j][2] * rstd * gg[2], v[j][3] * rstd * gg[3]); o8[64 * j] = w; }
}

struct Args { const float* in[14]; float* out; unsigned char* ws; };
#define WSP(type, off) ((type*)(ws + (off)))
__global__ void __launch_bounds__(NWAVES * 64, 2) fwd(Args args) {
    extern __shared__ __attribute__((aligned(16))) unsigned char lds_raw[];
    LAS unsigned char* lds = (LAS unsigned char*)lds_raw;
    const int G = gridDim.x, bx = blockIdx.x;
    unsigned char* const ws = args.ws;
    unsigned* const ctl = (unsigned*)(ws + WS_CTL);
    using pg8::Prob; using pg8::gemm_phase;

    const int wave = __builtin_amdgcn_readfirstlane((int)threadIdx.x >> 6);
    for (int u = threadIdx.x; u < (LDS_BYTES - LDSCTL_OFF) / 4; u += NWAVES * 64) ((LAS unsigned*)(lds + LDSCTL_OFF))[u] = 0u;
    __syncthreads();
    (void)xcd_barrier_post(ctl + CW_BAR, (volatile LAS unsigned*)(lds + MISC_OFF) + 8, wave == 0 && lane_id() == 0);
#define GRID_BAR() do { XcdBarrier _b; _b.bar = (unsigned*)(args.ws + WS_CTL) + CW_BAR; _b.x = xb_xcc_id(); _b.st = (volatile LAS unsigned*)(lds + MISC_OFF) + 8; xcd_barrier(_b, wave == 0 && lane_id() == 0); } while (0)
#define TIDS() const int lane = lane_id(), tid = wave * 64 + lane; \
    const int gw = bx * NWAVES + wave, ngw = G * NWAVES; const size_t gt = (size_t)bx * (NWAVES * 64) + tid, ngt = (size_t)G * (NWAVES * 64); (void)lane; (void)gw; (void)ngw; (void)gt; (void)ngt

    {
        TIDS();
        const float* w_in = args.in[4];
        LAS float* scr = (LAS float*)(lds + wave * TR_TILE_BYTES);
        bf16_t* WtA = WSP(bf16_t, WS_WTA);
        transpose_job(w_in, DM, 53248, 0, 12288, WtA, 0, 1.0f, scr, lane, gw, ngw);
        transpose_job(w_in, DM, 53248, 12288, 4096, WtA, 12288, 0.0625f, scr, lane, gw, ngw);
        transpose_job(w_in, DM, 53248, 16384, 8192, WSP(bf16_t, WS_WTV), 0, 1.0f, scr, lane, gw, ngw);
        transpose_job(w_in, DM, 53248, 24576, 8192, WtA, 16384, 1.0f, scr, lane, gw, ngw);
        transpose_job(w_in, DM, 53248, 32768, 4096, WtA, 24576, 0.03125f, scr, lane, gw, ngw);
        transpose_job(w_in, DM, 53248, 36864, 16384, WtA, 28672, 1.0f, scr, lane, gw, ngw);
#pragma unroll 1
        for (int g = 0; g < 4; ++g) transpose_job(args.in[5] + (size_t)g * 1024 * 1024, 1024, 1024, 0, 1024, WSP(bf16_t, WS_WG) + (size_t)g * 1024 * 1024, 0, 1.0f, scr, lane, gw, ngw);
        transpose_job(args.in[7], DM, DM, 0, DM, WSP(bf16_t, WS_WK), 0, 1.0f, scr, lane, gw, ngw);
        transpose_job(args.in[8], DM, DM, 0, DM, WSP(bf16_t, WS_WV), 0, 1.0f, scr, lane, gw, ngw);
        transpose_job(args.in[9], DM, DM, 0, DM, WSP(bf16_t, WS_WPP), 0, 1.0f, scr, lane, gw, ngw);
        transpose_job(args.in[10], 8192, DM, 0, DM, WSP(bf16_t, WS_WPR), 0, 1.0f, scr, lane, gw, ngw);
        transpose_job(args.in[11], DM, DM, 0, DM, WSP(bf16_t, WS_WPM), 0, 1.0f, scr, lane, gw, ngw);
        transpose_job(args.in[12], DM, DM, 0, DM, WSP(bf16_t, WS_WO), 0, 1.0f, scr, lane, gw, ngw);
        for (int m = gw; m < SEQ + MEML; m += ngw) {
            if (m < SEQ) rms_row_to_bf16(args.in[0] + (size_t)m * DM, args.in[2], WSP(bf16_t, WS_H) + (size_t)m * DM, lane);
            else rms_row_to_bf16(args.in[1] + (size_t)(m - SEQ) * DM, args.in[3], WSP(bf16_t, WS_MEMN) + (size_t)(m - SEQ) * DM, lane);
        }
        float* ropec = WSP(float, WS_ROPE); float* ropes = ropec + (size_t)SEQ * 128;
        for (size_t i = gt; i < (size_t)SEQ * 128; i += ngt) {
            const int pos = (int)(i >> 7), fi = (int)(i & 127);
            const float ang = (float)pos * c_inv[fi];
            const double rev = (double)ang * 0.15915494309189533577; const float fr_ = (float)(rev - __builtin_rint(rev));
            ropec[i] = __builtin_amdgcn_cosf(fr_); ropes[i] = __builtin_amdgcn_sinf(fr_);
        }
    }
    GRID_BAR();

    {
        { Prob<DM, DM, 8, 0, 0, 512, 0, 256 * DM, 512> p{WSP(bf16_t, WS_MEMN), WSP(bf16_t, WS_WK)}; pg8::BatchOrder S; S.init(8, 1, 16, G, bx);
          pg8::EpiF32Slab E{WSP(float, WS_KMP), DM, MEML * DM, 0, 256}; gemm_phase(lds, wave, p, S, E); }
        { Prob<DM, DM, 8, 256 * DM, 0, 512, 0, 0, 512> p{WSP(bf16_t, WS_WV), WSP(bf16_t, WS_MEMN)}; pg8::BatchOrder S; S.init(8, 16, 1, G, bx >= 128 ? bx - 128 : (1 << 20));
          pg8::EpiF32Slab E{WSP(float, WS_VMTP), 256, MEML * DM, 256 * 256, 0}; gemm_phase(lds, wave, p, S, E); }
        { Prob<DM, DM, DM / 64, 256 * DM, 0, 0, 0, 256 * DM, 0> p{WSP(bf16_t, WS_H), WSP(bf16_t, WS_WTA)}; pg8::StaticOrder S; S.init(SEQ / 256, LDZ / 256, G, bx, 4);
          pg8::EpiMain E{WSP(bf16_t, WS_Z), WSP(bf16_t, WS_PQ), WSP(bf16_t, WS_KDT), WSP(float, WS_ROPE), WSP(float, WS_ROPE) + (size_t)SEQ * 128}; gemm_phase<BIG_ALIGN, BIG_SP2>(lds, wave, p, S, E); }
        { Prob<DM, DM, DM / 64, 256 * DM, 0, 0, 0, 256 * DM, 0> p{WSP(bf16_t, WS_WTV), WSP(bf16_t, WS_H)}; pg8::StaticOrder S; S.init(8192 / 256, SEQ / 256, G, bx);
          pg8::EpiVt E{WSP(bf16_t, WS_VS)}; gemm_phase<BIG_ALIGN, BIG_SP2>(lds, wave, p, S, E); }
    }
    GRID_BAR();

    {
        {
            TIDS();
            const float* slab = WSP(float, WS_KMP); bf16_t* dst = WSP(bf16_t, WS_KM);
            for (size_t i = gt; i < (size_t)2 * MEML * DM / 4; i += ngt) {
                const size_t which = i / (MEML * DM / 4), off = (i % (MEML * DM / 4)) * 4;
                const float* sp = slab + which * ((size_t)8 * MEML * DM) + off;
                f32x4 a = *(const f32x4*)sp;
#pragma unroll
                for (int k = 1; k < 8; ++k) a += *(const f32x4*)(sp + (size_t)k * MEML * DM);
                u32x2 w; w.x = cvt_pk_bf16(a[0], a[1]); w.y = cvt_pk_bf16(a[2], a[3]);
                *(u32x2*)(dst + which * ((size_t)MEML * DM) + off) = w;
            }
        }
        {
            TIDS();
            const bf16_t* Z = WSP(bf16_t, WS_Z); bf16_t* Mixed = WSP(bf16_t, WS_MIXED);
            for (size_t i = gt; i < (size_t)(SEQ / 32) * 512; i += ngt) {
                const int c8 = (int)(i & 511), t0 = (int)(i >> 9) * 32, w = 2 << (c8 >> 7);
                const bf16_t* up = Z + ZO_U + c8 * 8;
                f32x4 s0 = (f32x4){0.f, 0.f, 0.f, 0.f}, s1 = s0;
#pragma unroll
                for (int k = 1; k <= 16; ++k) { const int tr = t0 - k; if (k <= w && tr >= 0) {     const u32x4 v = *(const u32x4*)(up + (size_t)tr * LDZ); s0 += bf4_lo(v); s1 += bf4_hi(v); } }
#pragma unroll 1
                for (int tt = 0; tt < 32; tt += 8) {
                    u32x4 a[8], b[8];
#pragma unroll
                    for (int k = 0; k < 8; ++k) a[k] = *(const u32x4*)(up + (size_t)(t0 + tt + k) * LDZ);
#pragma unroll
                    for (int k = 0; k < 8; ++k) { const int tr = t0 + tt + k - w; b[k] = (u32x4){0u, 0u, 0u, 0u}; if (tr >= 0) b[k] = *(const u32x4*)(up + (size_t)tr * LDZ); }
#pragma unroll
                    for (int k = 0; k < 8; ++k) { const int t = t0 + tt + k; const f32x4 u0 = bf4_lo(a[k]), u1 = bf4_hi(a[k]);
                        s0 += u0 - bf4_lo(b[k]); s1 += u1 - bf4_hi(b[k]);
                        const float rc = 1.0f / (float)((t + 1) < w ? (t + 1) : w);
                        *(u32x4*)(Mixed + (size_t)t * DM + c8 * 8) = pack8(s0 * rc - u0, s1 * rc - u1); }
                }
            }
        }
        { Prob<512, 256, 4, 512 * 512, 256 * 512, NCH * 512 * 512, 256 * 256, 0, NCH * 256 * 256> p{WSP(bf16_t, WS_VS), WSP(bf16_t, WS_KDT)}; pg8::BatchOrder S; S.init(NH, NCH, 2, G, bx);
          pg8::EpiPlain E{WSP(bf16_t, WS_KVT), 256, NCH * 512 * 256, 512 * 256, 256 * 256}; gemm_phase(lds, wave, p, S, E); }
        { Prob<LDZ, LDZ, 4, 256 * LDZ, 0, 256, 256 * LDZ, 0, 256> p{WSP(bf16_t, WS_Z) + ZO_Q, WSP(bf16_t, WS_Z) + ZO_K}; pg8::BatchOrder S; S.init(NH, NCH, 1, G, bx);
          pg8::EpiScores E{WSP(bf16_t, WS_PQ)}; gemm_phase(lds, wave, p, S, E); }
    }
    GRID_BAR();

    {
        {
            TIDS();
            for (size_t i = gt; i < (size_t)NH * 512 * 32; i += ngt) {
                const int d8 = (int)(i & 31), e = (int)((i >> 5) & 511), h = (int)(i >> 14);
                const float gc = __builtin_amdgcn_exp2f(256.0f * c_lg2g[h]);
                f32x4 s0 = (f32x4){0.f, 0.f, 0.f, 0.f}, s1 = s0;
                const bf16_t* kv = WSP(bf16_t, WS_KVT) + ((size_t)(h * NCH) * 512 + e) * 256 + d8 * 8;
                bf16_t* st = WSP(bf16_t, WS_VS) + ((size_t)(h * NCH) * 512 + e) * 512 + 256 + d8 * 8;
#pragma unroll 4
                for (int n = 0; n < NCH; ++n) {
                    *(u32x4*)(st + (size_t)n * 512 * 512) = pack8(s0, s1);
                    const u32x4 v = *(const u32x4*)(kv + (size_t)n * 512 * 256);
                    s0 = s0 * gc + bf4_lo(v); s1 = s1 * gc + bf4_hi(v);
                }
            }
        }
        { Prob<DM, 1024, 16, 256 * DM, 0, 1024, 0, 256 * 1024, 1024 * 1024> p{WSP(bf16_t, WS_MIXED), WSP(bf16_t, WS_WG)}; pg8::BatchOrder S; S.init(4, SEQ / 256, 4, G, bx);
          pg8::EpiPool E{args.in[6], WSP(bf16_t, WS_Z) + ZO_SGP, WSP(bf16_t, WS_POOLOUT)}; gemm_phase(lds, wave, p, S, E); }
        { Prob<LDZ, DM, 16, 256 * LDZ, 0, 1024, 0, 0, 1024> p{WSP(bf16_t, WS_Z) + ZO_QM, WSP(bf16_t, WS_KM)}; pg8::BatchOrder S; S.init(4, SEQ / 256, 1, G, bx);
          pg8::EpiMemS E{WSP(bf16_t, WS_PM), WSP(float, CTL_RSM)}; gemm_phase(lds, wave, p, S, E); }
    }
    GRID_BAR();

    {
        { Prob<512, 512, 8, 256 * 512, 0, SEQ * 512, 512 * 512, 256 * 512, NCH * 512 * 512> p{WSP(bf16_t, WS_PQ), WSP(bf16_t, WS_VS)}; pg8::BatchOrder S; S.init(NH, NCH, 2, G, bx);
        pg8::EpiRetOut E{WSP(bf16_t, WS_O), WSP(float, CTL_RS)}; gemm_phase(lds, wave, p, S, E); }
        { Prob<256, 256, 4, 256 * 256, 0, SEQ * 256, 0, 256 * 256, 1024 * 256> p{WSP(bf16_t, WS_PM), WSP(bf16_t, WS_VMT)}; pg8::BatchOrder S; S.init(4, SEQ / 256, 4, G, bx);
          pg8::EpiMemPV E{WSP(float, CTL_RSM), WSP(bf16_t, WS_Z) + ZO_SGM, WSP(bf16_t, WS_MEMOUT)}; gemm_phase(lds, wave, p, S, E); }
    }
    GRID_BAR();

    {
        TIDS();
        const float* RS = WSP(float, CTL_RS); const bf16_t* Ob = WSP(bf16_t, WS_O); const bf16_t* Z = WSP(bf16_t, WS_Z); bf16_t* RetOut = WSP(bf16_t, WS_RETOUT);
        for (size_t i0 = gt; i0 < (size_t)SEQ * 1024; i0 += 4 * ngt) {
            u32x4 o[4], g[4]; float rs[4];
#pragma unroll
            for (int k = 0; k < 4; ++k) { const size_t i = i0 + k * ngt; if (i < (size_t)SEQ * 1024) { const int c8 = (int)(i & 1023), t = (int)(i >> 10);
                o[k] = *(const u32x4*)(Ob + (size_t)t * 8192 + c8 * 8); g[k] = *(const u32x4*)(Z + (size_t)t * LDZ + ZO_SGR + c8 * 8); rs[k] = RS[(size_t)(c8 >> 6) * SEQ + t]; } }
#pragma unroll
            for (int k = 0; k < 4; ++k) { const size_t i = i0 + k * ngt; if (i < (size_t)SEQ * 1024) { const int c8 = (int)(i & 1023), t = (int)(i >> 10);
                const float rstd = 1.0f / sqrtf(rs[k] * (1.0f / DV) + NORM_EPS);
                *(u32x4*)(RetOut + (size_t)t * 8192 + c8 * 8) = pack8(bf4_lo(o[k]) * rstd * bf4_lo(g[k]), bf4_hi(o[k]) * rstd * bf4_hi(g[k])); } }
        }
    }
    GRID_BAR();

    {
        { Prob<DM, DM, DM / 64, 256 * DM, 0, 0, 0, 256 * DM, 0> p{WSP(bf16_t, WS_POOLOUT), WSP(bf16_t, WS_WPP)}; pg8::StaticOrder S; S.init(SEQ / 256, DM / 256, G, bx);
          pg8::EpiProj<0> E{WSP(bf16_t, WS_Z) + ZO_AP, WSP(float, WS_MG), WSP(bf16_t, WS_MERGED)}; gemm_phase<BIG_ALIGN, BIG_SP2>(lds, wave, p, S, E); }
        { Prob<8192, 8192, 8192 / 64, 256 * 8192, 0, 0, 0, 256 * 8192, 0> p{WSP(bf16_t, WS_RETOUT), WSP(bf16_t, WS_WPR)}; pg8::StaticOrder S; S.init(SEQ / 256, DM / 256, G, bx);
          pg8::EpiProj<1> E{WSP(bf16_t, WS_Z) + ZO_AR, WSP(float, WS_MG), WSP(bf16_t, WS_MERGED)}; gemm_phase<BIG_ALIGN, BIG_SP2>(lds, wave, p, S, E); }
        { Prob<DM, DM, DM / 64, 256 * DM, 0, 0, 0, 256 * DM, 0> p{WSP(bf16_t, WS_MEMOUT), WSP(bf16_t, WS_WPM)}; pg8::StaticOrder S; S.init(SEQ / 256, DM / 256, G, bx);
          pg8::EpiProj<2> E{WSP(bf16_t, WS_Z) + ZO_AM, WSP(float, WS_MG), WSP(bf16_t, WS_MERGED)}; gemm_phase<BIG_ALIGN, BIG_SP2>(lds, wave, p, S, E); }
    }
    GRID_BAR();

    {
        Prob<DM, DM, DM / 64, 256 * DM, 0, 0, 0, 256 * DM, 0> p{WSP(bf16_t, WS_MERGED), WSP(bf16_t, WS_WO)}; pg8::StaticOrder S; S.init(SEQ / 256, DM / 256, G, bx);
        pg8::EpiOutProj E{args.in[0], args.out, WSP(float, CTL_RSO)}; gemm_phase<BIG_ALIGN, BIG_SP2>(lds, wave, p, S, E);
    }
    GRID_BAR();

    {
        TIDS();
        const bool bad = xb_ld(ctl + CW_BAR + XB_TMO) != 0u;
        const float* RSo = WSP(float, CTL_RSO); const float* norm_f = args.in[13]; float* out = args.out;
        const float qn = __builtin_nanf("");
        for (size_t i0 = gt; i0 < (size_t)SEQ * 1024; i0 += 4 * ngt) {
            f32x4 v[4], nf[4]; float rs[4];
#pragma unroll
            for (int k = 0; k < 4; ++k) { const size_t i = i0 + k * ngt; if (i < (size_t)SEQ * 1024) { const int c4 = (int)(i & 1023), t = (int)(i >> 10);
                v[k] = *(const f32x4*)(out + (size_t)t * DM + c4 * 4); nf[k] = *(const f32x4*)(norm_f + c4 * 4); rs[k] = RSo[t]; } }
#pragma unroll
            for (int k = 0; k < 4; ++k) { const size_t i = i0 + k * ngt; if (i < (size_t)SEQ * 1024) { const int c4 = (int)(i & 1023), t = (int)(i >> 10);
                const float rstd = 1.0f / sqrtf(rs[k] * (1.0f / DM) + NORM_EPS);
                f32x4 r = v[k] * rstd * nf[k]; if (bad) r = (f32x4){qn, qn, qn, qn};
                *(f32x4*)(out + (size_t)t * DM + c4 * 4) = r; } }
        }
    }
}

extern "C" void kernel_launch(void* const* d_in, const int* in_sizes, int n_in, void* d_out, int out_size, void* d_ws, size_t ws_size, hipStream_t stream) {
    static int grid = 0;
    if (grid == 0) {
        if (n_in != 14 || out_size != SEQ * DM || ws_size < WS_END) { fprintf(stderr, "kernel_launch: unexpected shapes (n_in %d, out %d, ws %zu < %zu); nothing launched\n", n_in, out_size, ws_size, (size_t)WS_END); grid = -1; return; }
        int dev = 0, cus = 0, per_cu = 0;
        if (hipGetDevice(&dev) != hipSuccess || hipDeviceGetAttribute(&cus, hipDeviceAttributeMultiprocessorCount, dev) != hipSuccess) { grid = -1; return; }
        if (hipFuncSetAttribute((const void*)fwd, hipFuncAttributeMaxDynamicSharedMemorySize, LDS_BYTES) != hipSuccess) { fprintf(stderr, "kernel_launch: hipFuncSetAttribute failed\n"); grid = -1; return; }
        if (hipOccupancyMaxActiveBlocksPerMultiprocessor(&per_cu, (const void*)fwd, NWAVES * 64, LDS_BYTES) != hipSuccess || per_cu < 1) fprintf(stderr, "kernel_launch: occupancy query reports %d\n", per_cu);
        (void)hipGetLastError();
        grid = cus;
    }
    if (grid < 0) return;
    (void)in_sizes;
    if (hipMemsetAsync((char*)d_ws + WS_CTL, 0, CTL_ZERO_BYTES, stream) != hipSuccess) return;
    Args a{};
    for (int i = 0; i < 14; ++i) a.in[i] = (const float*)d_in[i];
    a.out = (float*)d_out; a.ws = (unsigned char*)d_ws;
    hipLaunchKernelGGL(fwd, dim3(grid), dim3(NWAVES * 64), LDS_BYTES, stream, a);
}
```

```cpp
#include <hip/hip_runtime.h>
#include <cstdio>
#include <cstdint>
#ifndef BIG_ALIGN
#define BIG_ALIGN true
#endif
#ifndef BIG_SP2
#define BIG_SP2 true
#endif

#define LAS __attribute__((address_space(3)))
#define GAS __attribute__((address_space(1)))
typedef unsigned short bf16_t;
typedef short bf16x8 __attribute__((ext_vector_type(8)));
typedef float f32x4 __attribute__((ext_vector_type(4)));
typedef float f32x2 __attribute__((ext_vector_type(2)));
typedef unsigned u32x4 __attribute__((ext_vector_type(4)));
typedef unsigned u32x2 __attribute__((ext_vector_type(2)));

constexpr int SEQ = 8192, DM = 4096, MEML = 256, LDZ = 45056;
constexpr int NH = 16, DK = 256, DV = 512, CH = 256, NCH = SEQ / CH;
constexpr int ZO_U = 0, ZO_SGP = 4096, ZO_Q = 8192, ZO_K = 12288, ZO_SGR = 16384, ZO_QM = 24576, ZO_SGM = 28672, ZO_AP = 32768, ZO_AR = 36864, ZO_AM = 40960;
constexpr float NORM_EPS = 1e-6f;
constexpr int NWAVES = 8;

__device__ const float c_lg2g[16] = {
    -4.580368961e-02f, -2.272007650e-02f, -1.131531323e-02f, -5.646563141e-03f, -2.820519062e-03f, -1.409570255e-03f, -7.046129766e-04f, -3.522634716e-04f,
    -1.761209843e-04f, -8.805780458e-05f, -4.402823044e-05f, -2.201394726e-05f, -1.100693164e-05f, -5.503455325e-06f, -2.751725038e-06f, -1.375861863e-06f};
__device__ const float c_inv[128] = {
    1.000000000e+00f, 9.305720329e-01f, 8.659643531e-01f, 8.058421612e-01f, 7.498942018e-01f, 6.978305578e-01f, 6.493816376e-01f, 6.042963862e-01f, 5.623413324e-01f, 5.232990980e-01f, 4.869675338e-01f, 4.531583786e-01f, 4.216965139e-01f, 3.924189806e-01f, 3.651741147e-01f, 3.398208320e-01f,
    3.162277639e-01f, 2.942727208e-01f, 2.738419771e-01f, 2.548296750e-01f, 2.371373773e-01f, 2.206734121e-01f, 2.053525001e-01f, 1.910952926e-01f, 1.778279394e-01f, 1.654817164e-01f, 1.539926529e-01f, 1.433012635e-01f, 1.333521456e-01f, 1.240937784e-01f, 1.154781953e-01f, 1.074607819e-01f,
    1.000000015e-01f, 9.305720776e-02f, 8.659642935e-02f, 8.058422059e-02f, 7.498942316e-02f, 6.978306174e-02f, 6.493816525e-02f, 6.042964011e-02f, 5.623413250e-02f, 5.232991278e-02f, 4.869675264e-02f, 4.531583562e-02f, 4.216964915e-02f, 3.924189880e-02f, 3.651741147e-02f, 3.398208320e-02f,
    3.162277490e-02f, 2.942727134e-02f, 2.738419548e-02f, 2.548296750e-02f, 2.371373773e-02f, 2.206734009e-02f, 2.053525113e-02f, 1.910953037e-02f, 1.778279431e-02f, 1.654817164e-02f, 1.539926510e-02f, 1.433012541e-02f, 1.333521400e-02f, 1.240937784e-02f, 1.154781971e-02f, 1.074607857e-02f,
    9.999999776e-03f, 9.305720218e-03f, 8.659643121e-03f, 8.058422245e-03f, 7.498942316e-03f, 6.978305988e-03f, 6.493816152e-03f, 6.042963825e-03f, 5.623413250e-03f, 5.232991185e-03f, 4.869675264e-03f, 4.531583749e-03f, 4.216964822e-03f, 3.924189601e-03f, 3.651741194e-03f, 3.398208413e-03f,
    3.162277630e-03f, 2.942727180e-03f, 2.738419687e-03f, 2.548296703e-03f, 2.371373819e-03f, 2.206734149e-03f, 2.053525066e-03f, 1.910952968e-03f, 1.778279431e-03f, 1.654817141e-03f, 1.539926510e-03f, 1.433012541e-03f, 1.333521446e-03f, 1.240937738e-03f, 1.154782018e-03f, 1.074607833e-03f,
    1.000000047e-03f, 9.305720450e-04f, 8.659643354e-04f, 8.058421663e-04f, 7.498941850e-04f, 6.978305755e-04f, 6.493816036e-04f, 6.042963942e-04f, 5.623413017e-04f, 5.232990952e-04f, 4.869675322e-04f, 4.531583691e-04f, 4.216965172e-04f, 3.924189659e-04f, 3.651741135e-04f, 3.398208355e-04f,
    3.162277571e-04f, 2.942727297e-04f, 2.738419571e-04f, 2.548296761e-04f, 2.371373703e-04f, 2.206734061e-04f, 2.053525095e-04f, 1.910952997e-04f, 1.778279402e-04f, 1.654817170e-04f, 1.539926598e-04f, 1.433012512e-04f, 1.333521504e-04f, 1.240937709e-04f, 1.154782003e-04f, 1.074607862e-04f};

constexpr size_t MiB = 1u << 20;
constexpr size_t WS_CTL = 0, CTL_ZERO_BYTES = 4 * MiB;
constexpr int CW_BAR = 4096;
constexpr size_t CTL_RS = 1 * MiB;
constexpr size_t CTL_RSM = 1 * MiB + 512 * 1024;
constexpr size_t CTL_RSO = 1 * MiB + 768 * 1024;
constexpr size_t WS_WTA = CTL_ZERO_BYTES;
constexpr size_t WS_WTV = WS_WTA + (size_t)LDZ * DM * 2;
constexpr size_t WS_WG = WS_WTV + (size_t)8192 * DM * 2;
constexpr size_t WS_WK = WS_WG + (size_t)4 * 1024 * 1024 * 2;
constexpr size_t WS_WV = WS_WK + (size_t)DM * DM * 2;
constexpr size_t WS_WPP = WS_WV + (size_t)DM * DM * 2;
constexpr size_t WS_WPR = WS_WPP + (size_t)DM * DM * 2;
constexpr size_t WS_WPM = WS_WPR + (size_t)DM * 8192 * 2;
constexpr size_t WS_WO = WS_WPM + (size_t)DM * DM * 2;
constexpr size_t WS_H = WS_WO + (size_t)DM * DM * 2;
constexpr size_t WS_MEMN = WS_H + (size_t)SEQ * DM * 2;
constexpr size_t WS_ROPE = WS_MEMN + (size_t)MEML * DM * 2;
constexpr size_t WS_Z = WS_ROPE + (size_t)2 * SEQ * 128 * 4;
constexpr size_t WS_VS = WS_Z + (size_t)SEQ * LDZ * 2;
constexpr size_t WS_PQ = WS_VS + (size_t)NH * NCH * 512 * 512 * 2;
constexpr size_t WS_KDT = WS_PQ + (size_t)NH * SEQ * 512 * 2;
constexpr size_t WS_KVT = WS_KDT + (size_t)NH * NCH * 256 * 256 * 2;
constexpr size_t WS_O = WS_KVT + (size_t)NH * NCH * 512 * 256 * 2;
constexpr size_t WS_PROJA = WS_O + (size_t)SEQ * 8192 * 2;
constexpr size_t PROJA_SLOT = (size_t)SEQ * DM * 2;
constexpr size_t WS_POOLOUT = WS_PROJA, WS_RETLO = WS_PROJA + PROJA_SLOT, WS_MEMOUT = WS_PROJA + 3 * PROJA_SLOT;
constexpr size_t WS_MIXED = WS_PROJA + 4 * PROJA_SLOT;
constexpr size_t WS_KM = WS_MIXED + (size_t)SEQ * DM * 2;
constexpr size_t WS_VMT = WS_KM + (size_t)MEML * DM * 2;
constexpr size_t WS_PM = WS_VMT + (size_t)MEML * DM * 2;
constexpr size_t WS_MERGED = WS_PM + (size_t)4 * SEQ * 256 * 2;
constexpr size_t WS_KMP = WS_MERGED + (size_t)SEQ * DM * 2;
constexpr size_t WS_VMTP = WS_KMP + (size_t)8 * MEML * DM * 4;
constexpr size_t WS_END = WS_VMTP + (size_t)8 * MEML * DM * 4;

constexpr int RING_BYTES = 131072;
constexpr int TR_TILE_BYTES = 64 * 65 * 4;
constexpr int LDSCTL_OFF = 8 * TR_TILE_BYTES, MISC_OFF = LDSCTL_OFF + 320;
static_assert(LDSCTL_OFF >= RING_BYTES, "LDS map");
constexpr int LDS_BYTES = 147456;

__device__ __forceinline__ unsigned cvt_pk_bf16(float lo, float hi) { unsigned r; asm volatile("v_cvt_pk_bf16_f32 %0, %1, %2" : "=v"(r) : "v"(lo), "v"(hi)); return r; }
__device__ __forceinline__ float bf_lo(unsigned w) { return __uint_as_float(w << 16); }
__device__ __forceinline__ float bf_hi(unsigned w) { return __uint_as_float(w & 0xffff0000u); }
__device__ __forceinline__ f32x4 bf4_lo(u32x4 g) { return (f32x4){bf_lo(g.x), bf_hi(g.x), bf_lo(g.y), bf_hi(g.y)}; }
__device__ __forceinline__ f32x4 bf4_hi(u32x4 g) { return (f32x4){bf_lo(g.z), bf_hi(g.z), bf_lo(g.w), bf_hi(g.w)}; }
__device__ __forceinline__ u32x4 pack8(f32x4 a, f32x4 b) { u32x4 w; w.x = cvt_pk_bf16(a[0], a[1]); w.y = cvt_pk_bf16(a[2], a[3]); w.z = cvt_pk_bf16(b[0], b[1]); w.w = cvt_pk_bf16(b[2], b[3]); return w; }
__device__ __forceinline__ float sigm(float x) { return __builtin_amdgcn_rcpf(1.0f + __builtin_amdgcn_exp2f(-1.44269504f * x)); }
__device__ __forceinline__ void atomic_addf(float* p, float v) { (void)__hip_atomic_fetch_add(p, v, __ATOMIC_RELAXED, __HIP_MEMORY_SCOPE_AGENT); }
__device__ __forceinline__ int lane_id() { int l = (int)__builtin_amdgcn_mbcnt_hi(~0u, __builtin_amdgcn_mbcnt_lo(~0u, 0u)); asm volatile("" : "+v"(l)); return l; }
__device__ __forceinline__ float shx(float v, int lane, int mask) { return __int_as_float(__builtin_amdgcn_ds_bpermute((lane ^ mask) << 2, __float_as_int(v))); }
__device__ __forceinline__ float wave_sum(float v, int lane) {
#pragma unroll
    for (int o = 1; o < 64; o <<= 1) v += shx(v, lane, o);
    return v;
}

#define LDS_WAIT() asm volatile("s_waitcnt lgkmcnt(0)" ::: "memory")
namespace pg8 {
constexpr int BM = 256, BK = 64, HALF = 128, HTB = HALF * BK * 2, STAGE_BYTES = 8 * HTB, NXCD = 8, WGM = 8;
__host__ __device__ __forceinline__ int lds_byte(int r, int c) { const int st = (r >> 4) * 2 + (c >> 5), rr = r & 15, cc = c & 31, ob = rr * 64 + cc * 2; return st * 1024 + (ob ^ (((ob >> 9) & 1) << 5)); }
__host__ __device__ __forceinline__ void stage_rc(int b, int& R, int& C) { const int st = b / 1024, sb = b % 1024, swz = sb ^ (((sb >> 9) & 1) << 5); R = (st >> 1) * 16 + swz / 64; C = (st & 1) * 32 + (swz % 64) / 2; }
__host__ __device__ __forceinline__ int perm32(int rho) { const int n = rho >> 4, i = rho & 15; return 8 * (i >> 2) + 4 * n + (i & 3); }

struct Unit { int pm, pn, b, aux; };

struct StaticOrder {
    int nM, nN, nwg, G, c, wgm;
    __device__ void init(int nM_, int nN_, int G_, int c_, int wgm_ = 8) { nM = nM_; nN = nN_; nwg = nM * nN; G = G_; c = c_; wgm = wgm_; }
    __device__ bool next(int i, Unit& u) const {
        const long L = (long)i * G + c; if (L >= nwg) return false;
        int wgid = (int)L; { const int q = nwg / NXCD, r = nwg % NXCD, xcd = wgid % NXCD, off = wgid / NXCD; wgid = (xcd < r ? xcd * (q + 1) : r * (q + 1) + (xcd - r) * q) + off; }
        const int nig = wgm * nN, gid = wgid / nig, fm = gid * wgm, gsz = (nM - fm) < wgm ? (nM - fm) : wgm;
        u.pm = fm + ((wgid % nig) % gsz); u.pn = (wgid % nig) / gsz; u.b = 0; u.aux = 0; return true;
    }
    __device__ __forceinline__ void a_ready(const Unit&) const {}
    __device__ __forceinline__ void done(const Unit&) const {}
};
struct BatchOrder {
    int nM, nN, total, G, c;
    __device__ void init(int nb, int nM_, int nN_, int G_, int c_) { nM = nM_; nN = nN_; total = nb * nM * nN; G = G_; c = c_; }
    __device__ bool next(int i, Unit& u) const {
        const int L = i * G + c; if (L >= total) return false;
        u.pn = L % nN; const int t = L / nN; u.pm = t % nM; u.b = t / nM; u.aux = 0; return true;
    }
    __device__ __forceinline__ void a_ready(const Unit&) const {}
    __device__ __forceinline__ void done(const Unit&) const {}
};
struct PairOrder {
    int G, c;
    __device__ void init(int G_, int c_) { G = G_; c = c_; }
    __device__ bool next(int i, Unit& u) const {
        const int q = (i >> 1) * G + c; if (q >= NH * NCH) return false;
        u.pn = i & 1; u.pm = q % NCH; u.b = q / NCH; u.aux = i >> 1; return true;
    }
    __device__ __forceinline__ void a_ready(const Unit&) const {}
    __device__ __forceinline__ void done(const Unit&) const {}
};
struct MergeOrder {
    StaticOrder T;
    __device__ void init(int nM_, int nN_, int G_, int c_) { T.init(nM_, nN_, G_, c_); }
    __device__ bool next(int i, Unit& u) const { if (!T.next(i >> 2, u)) return false; u.b = i & 3; return true; }
    __device__ __forceinline__ void a_ready(const Unit&) const {}
    __device__ __forceinline__ void done(const Unit&) const {}
};
template <int LDA, int LDB, int NT, int A_PM, int A_PN, int A_B, int B_PM, int B_PN, int B_B>
struct Prob {
    const bf16_t* A; const bf16_t* B;
    static constexpr int lda = LDA, ldb = LDB, nt = NT;
    __device__ __forceinline__ const char* a_base(const Unit& u) const { return (const char*)(A + (u.pm * A_PM + u.pn * A_PN + u.b * A_B)); }
    __device__ __forceinline__ const char* b_base(const Unit& u) const { return (const char*)(B + (u.pm * B_PM + u.pn * B_PN + u.b * B_B)); }
};

template <bool ALIGN_EPI = true, bool SP2 = true, bool KEEP_ACC = false, class ProbT, class Epi, class Sched>
__device__ __forceinline__ void gemm_phase(LAS unsigned char* lds, const int wid, const ProbT P, const Sched& S, const Epi& E) {
    const int lane = lane_id(), tid = wid * 64 + lane, wr = wid >> 2, wc = wid & 3, fr = lane & 15, fq = lane >> 4;
    constexpr int nt = ProbT::nt;
    unsigned voffA[2], voffB[2];
#pragma unroll
    for (int i = 0; i < 2; ++i) { int R, C; stage_rc(tid * 16 + i * 8192, R, C); const int Rb = Epi::PERM ? ((R & ~31) + perm32(R & 31)) : R;
        voffA[i] = (unsigned)(R * ProbT::lda + C) * 2u; voffB[i] = (unsigned)(Rb * ProbT::ldb + C) * 2u; }
    const size_t kstep = (size_t)(BK * 2);
    constexpr size_t hstepA = (size_t)HALF * ProbT::lda * 2, hstepB = (size_t)HALF * ProbT::ldb * 2;
    const unsigned ldsw = (unsigned)wid * 1024u;
    const int aoff = lds_byte(wr * 64 + fr, fq * 8), boff = lds_byte(wc * 32 + fr, fq * 8);
#define PG8_SA(b, h) (((b) * 2 + (h)) * HTB)
#define PG8_SB(b, h) ((4 + (b) * 2 + (h)) * HTB)
#define PG8_STAGE(bufoff, gbase, voff) do { _Pragma("unroll") for (int _i = 0; _i < 2; ++_i) \
        __builtin_amdgcn_global_load_lds((const unsigned*)((const char*)(gbase) + (voff)[_i]), (LAS unsigned*)(lds + (bufoff) + ldsw + _i * 8192), 16, 0, 0); } while (0)
#define PG8_LDA(dst, b, h) do { _Pragma("unroll") for (int m = 0; m < 4; ++m) _Pragma("unroll") for (int k = 0; k < 2; ++k) dst[m][k] = *(const LAS bf16x8*)(lds + PG8_SA(b, h) + aoff + m * 2048 + k * 1024); } while (0)
#define PG8_LDB(dst, b, h) do { _Pragma("unroll") for (int n = 0; n < 2; ++n) _Pragma("unroll") for (int k = 0; k < 2; ++k) dst[n][k] = *(const LAS bf16x8*)(lds + PG8_SB(b, h) + boff + n * 2048 + k * 1024); } while (0)
#define PG8_MMA(ai, bj, At, Bt) do { __builtin_amdgcn_s_setprio(1); _Pragma("unroll") for (int m = 0; m < 4; ++m) _Pragma("unroll") for (int n = 0; n < 2; ++n) _Pragma("unroll") for (int k = 0; k < 2; ++k) \
        acc[ai][bj][m][n] = __builtin_amdgcn_mfma_f32_16x16x32_bf16(Bt[n][k], At[m][k], acc[ai][bj][m][n], 0, 0, 0); __builtin_amdgcn_s_setprio(0); } while (0)
#define PG8_WAIT_V(n) asm volatile("s_waitcnt vmcnt(" #n ")" ::: "memory")
#define PG8_WAIT_L(n) asm volatile("s_waitcnt lgkmcnt(" #n ")" ::: "memory")
#define PG8_BAR __builtin_amdgcn_s_barrier()
#define PG8_SCHED __builtin_amdgcn_sched_barrier(0)
    Unit cur, nxt; int ui = 0;
    if (!S.next(0, cur)) return;
    f32x4 acc[2][2][4][2];
#pragma unroll
    for (int a = 0; a < 2; ++a)
#pragma unroll
        for (int b = 0; b < 2; ++b)
#pragma unroll
            for (int m = 0; m < 4; ++m)
#pragma unroll
                for (int n = 0; n < 2; ++n) acc[a][b][m][n] = (f32x4){0.f, 0.f, 0.f, 0.f};
    bf16x8 At[4][2], B0[2][2], B1[2][2];
    const char* cA = P.a_base(cur); const char* cB = P.b_base(cur);
    S.a_ready(cur);
    if constexpr (SP2) {
    PG8_STAGE(PG8_SB(0, 0), cB, voffB); PG8_STAGE(PG8_SB(0, 1), cB + hstepB, voffB); PG8_STAGE(PG8_SA(0, 0), cA, voffA); PG8_STAGE(PG8_SA(0, 1), cA + hstepA, voffA);
    if (wr == 1) PG8_BAR;
    PG8_WAIT_V(2); PG8_BAR;
    PG8_STAGE(PG8_SB(1, 0), cB + kstep, voffB); PG8_STAGE(PG8_SA(1, 0), cA + kstep, voffA); PG8_STAGE(PG8_SB(1, 1), cB + hstepB + kstep, voffB);
    PG8_WAIT_V(6); PG8_BAR;
    } else {
    PG8_STAGE(PG8_SB(0, 0), cB, voffB); PG8_STAGE(PG8_SA(0, 0), cA, voffA); PG8_STAGE(PG8_SB(0, 1), cB + hstepB, voffB); PG8_STAGE(PG8_SA(0, 1), cA + hstepA, voffA);
    if (wr == 1) PG8_BAR;
    PG8_WAIT_V(4); PG8_BAR;
    PG8_STAGE(PG8_SB(1, 0), cB + kstep, voffB); PG8_STAGE(PG8_SA(1, 0), cA + kstep, voffA); PG8_STAGE(PG8_SB(1, 1), cB + hstepB + kstep, voffB);
    PG8_WAIT_V(6); PG8_BAR;
    }
    for (;;) {
        const bool has_next = S.next(ui + 1, nxt);
        const char* nA = has_next ? P.a_base(nxt) : cA; const char* nB = has_next ? P.b_base(nxt) : cB;
        for (int t = 0; t < nt; t += 2) {
            const bool last = (t == nt - 2);
            const char* a1 = cA + (size_t)(t + 1) * kstep;
            const char* a2 = last ? nA : cA + (size_t)(t + 2) * kstep; const char* b2 = last ? nB : cB + (size_t)(t + 2) * kstep;
            const char* a3 = a2 + kstep; const char* b3 = b2 + kstep;
            if (last && has_next) S.a_ready(nxt);
            if constexpr (SP2) {
            PG8_LDB(B0, 0, 0); PG8_LDB(B1, 0, 1); PG8_SCHED; PG8_LDA(At, 0, 0); PG8_STAGE(PG8_SA(1, 1), a1 + hstepA, voffA);
            PG8_WAIT_V(8); PG8_WAIT_L(0); PG8_BAR; PG8_MMA(0, 0, At, B0); PG8_MMA(0, 1, At, B1); PG8_BAR; PG8_SCHED;
            PG8_LDA(At, 0, 1); PG8_STAGE(PG8_SB(0, 0), b2, voffB); PG8_STAGE(PG8_SB(0, 1), b2 + hstepB, voffB); PG8_STAGE(PG8_SA(0, 0), a2, voffA);
            PG8_WAIT_V(8); PG8_WAIT_L(0); PG8_BAR; PG8_MMA(1, 0, At, B0); PG8_MMA(1, 1, At, B1); PG8_BAR; PG8_SCHED;
            PG8_LDB(B0, 1, 0); PG8_LDB(B1, 1, 1); PG8_SCHED; PG8_LDA(At, 1, 0); PG8_STAGE(PG8_SA(0, 1), a2 + hstepA, voffA);
            PG8_WAIT_V(8); PG8_WAIT_L(0); PG8_BAR; PG8_MMA(0, 0, At, B0); PG8_MMA(0, 1, At, B1); PG8_BAR; PG8_SCHED;
            PG8_LDA(At, 1, 1); PG8_STAGE(PG8_SB(1, 0), b3, voffB); PG8_STAGE(PG8_SB(1, 1), b3 + hstepB, voffB); PG8_STAGE(PG8_SA(1, 0), a3, voffA);
            PG8_WAIT_V(8); PG8_WAIT_L(0); PG8_BAR; PG8_MMA(1, 0, At, B0); PG8_MMA(1, 1, At, B1); PG8_BAR; PG8_SCHED;
            } else {
            PG8_LDB(B0, 0, 0); PG8_SCHED; PG8_LDA(At, 0, 0); PG8_STAGE(PG8_SA(1, 1), a1 + hstepA, voffA);
            PG8_WAIT_L(8); PG8_BAR; PG8_WAIT_L(0); PG8_MMA(0, 0, At, B0); PG8_BAR; PG8_SCHED;
            PG8_LDB(B1, 0, 1); PG8_STAGE(PG8_SB(0, 0), b2, voffB);
            PG8_BAR; PG8_WAIT_L(0); PG8_MMA(0, 1, At, B1); PG8_BAR;
            PG8_LDA(At, 0, 1); PG8_STAGE(PG8_SA(0, 0), a2, voffA);
            PG8_BAR; PG8_WAIT_L(0); PG8_MMA(1, 0, At, B0); PG8_BAR; PG8_SCHED;
            PG8_STAGE(PG8_SB(0, 1), b2 + hstepB, voffB);
            PG8_WAIT_V(6); PG8_BAR; PG8_MMA(1, 1, At, B1); PG8_BAR;
            PG8_LDB(B0, 1, 0); PG8_SCHED; PG8_LDA(At, 1, 0); PG8_STAGE(PG8_SA(0, 1), a2 + hstepA, voffA);
            PG8_WAIT_L(8); PG8_BAR; PG8_WAIT_L(0); PG8_MMA(0, 0, At, B0); PG8_BAR; PG8_SCHED;
            PG8_LDB(B1, 1, 1); PG8_STAGE(PG8_SB(1, 0), b3, voffB);
            PG8_BAR; PG8_WAIT_L(0); PG8_MMA(0, 1, At, B1); PG8_BAR;
            PG8_LDA(At, 1, 1); PG8_STAGE(PG8_SA(1, 0), a3, voffA);
            PG8_BAR; PG8_WAIT_L(0); PG8_MMA(1, 0, At, B0); PG8_BAR; PG8_SCHED;
            PG8_STAGE(PG8_SB(1, 1), b3 + hstepB, voffB);
            PG8_WAIT_V(6); PG8_BAR; PG8_MMA(1, 1, At, B1); PG8_BAR;
            }
        }
        if constexpr (ALIGN_EPI) { if (wr == 0) PG8_BAR; }
        E(acc, cur, wr, wc); S.done(cur);
        if (!has_next) break;
        bool reset = true; if constexpr (KEEP_ACC) reset = !E.keep(cur);
        if (reset) {
#pragma unroll
        for (int a = 0; a < 2; ++a)
#pragma unroll
            for (int b = 0; b < 2; ++b)
#pragma unroll
                for (int m = 0; m < 4; ++m)
#pragma unroll
                    for (int n = 0; n < 2; ++n) acc[a][b][m][n] = (f32x4){0.f, 0.f, 0.f, 0.f};
        }
        cur = nxt; cA = nA; cB = nB; ++ui;
        if constexpr (ALIGN_EPI) { if (wr == 1) PG8_BAR; }
    }
    PG8_WAIT_V(0);
    if constexpr (!ALIGN_EPI) { if (wr == 0) PG8_BAR; }
    PG8_BAR;
#undef PG8_SA
#undef PG8_SB
#undef PG8_STAGE
#undef PG8_LDA
#undef PG8_LDB
#undef PG8_MMA
#undef PG8_WAIT_V
#undef PG8_WAIT_L
#undef PG8_BAR
#undef PG8_SCHED
}

typedef const f32x4 (&AccRef)[2][2][4][2];
#define ROWG(ai, m) ({ int _r = (ai) * 128 + (m) * 16; asm volatile("" : "+v"(_r)); _r; })

struct EpiPlain {
    static constexpr bool PERM = true;
    bf16_t* O; int ldc, sb, spm, spn;
    __device__ __forceinline__ void operator()(AccRef acc, const Unit& u, int wr, int wc) const {
        const int lane_ = lane_id(), fr = lane_ & 15, fq = lane_ >> 4;
        bf16_t* base = O + (u.b * sb + u.pm * spm + u.pn * spn) + (wr * 64 + fr) * ldc + wc * 32 + fq * 8;
#pragma unroll
        for (int ai = 0; ai < 2; ++ai)
#pragma unroll
            for (int m = 0; m < 4; ++m)
#pragma unroll
                for (int bj = 0; bj < 2; ++bj) *(u32x4*)(base + (size_t)(ai * 128 + m * 16) * ldc + bj * 128) = pack8(acc[ai][bj][m][0], acc[ai][bj][m][1]);
    }
};

struct EpiF32Slab {
    static constexpr bool PERM = false;
    float* O; int ldc, sb, spm, spn;
    __device__ __forceinline__ void operator()(AccRef acc, const Unit& u, int wr, int wc) const {
        const int lane_ = lane_id(), fr = lane_ & 15, fq = lane_ >> 4;
        float* base = O + (u.b * sb + u.pm * spm + u.pn * spn) + (wr * 64 + fr) * ldc + wc * 32 + fq * 4;
#pragma unroll
        for (int ai = 0; ai < 2; ++ai)
#pragma unroll
            for (int m = 0; m < 4; ++m)
#pragma unroll
                for (int bj = 0; bj < 2; ++bj)
#pragma unroll
                    for (int n = 0; n < 2; ++n) *(f32x4*)(base + (size_t)(ai * 128 + m * 16) * ldc + bj * 128 + n * 16) = acc[ai][bj][m][n];
    }
};

struct EpiMain {
    static constexpr bool PERM = true;
    bf16_t* Z; bf16_t* PQ; bf16_t* KdT; const float* ropec; const float* ropes;
    __device__ __forceinline__ void operator()(AccRef acc, const Unit& u, int wr, int wc) const {
        const int lane_ = lane_id(), fr = lane_ & 15, fq = lane_ >> 4;
        const int pn = u.pn, lr0 = wr * 64 + fr, lc = wc * 32 + fq * 8;
        bf16_t* zb = Z + (size_t)(u.pm * 256 + lr0) * LDZ + pn * 256 + lc;
        if (pn >= 32 && pn < 64) {
            const bool isk = pn >= 48; const int head = (pn - 32) & 15; const float lg = c_lg2g[head];
#pragma unroll
            for (int ai = 0; ai < 2; ++ai)
#pragma unroll
                for (int m = 0; m < 4; ++m) {
                    const int rg = ROWG(ai, m), il = lr0 + rg, row = u.pm * 256 + il;
                    const f32x4 c0 = *(const f32x4*)(ropec + (size_t)row * 128 + lc), c1 = *(const f32x4*)(ropec + (size_t)row * 128 + lc + 4);
                    const f32x4 s0 = *(const f32x4*)(ropes + (size_t)row * 128 + lc), s1 = *(const f32x4*)(ropes + (size_t)row * 128 + lc + 4);
                    const f32x4 x10 = acc[ai][0][m][0], x11 = acc[ai][0][m][1], x20 = acc[ai][1][m][0], x21 = acc[ai][1][m][1];
                    const f32x4 y10 = x10 * c0 - x20 * s0, y11 = x11 * c1 - x21 * s1, y20 = x20 * c0 + x10 * s0, y21 = x21 * c1 + x11 * s1;
                    bf16_t* zr = zb + (size_t)rg * LDZ;
                    *(u32x4*)zr = pack8(y10, y11); *(u32x4*)(zr + 128) = pack8(y20, y21);
                    if (!isk) {
                        const float dq = __builtin_amdgcn_exp2f((float)(il + 1) * lg);
                        bf16_t* pq = PQ + ((size_t)head * SEQ + row) * 512 + 256 + lc;
                        *(u32x4*)pq = pack8(y10 * dq, y11 * dq); *(u32x4*)(pq + 128) = pack8(y20 * dq, y21 * dq);
                    } else {
                        const float dk = __builtin_amdgcn_exp2f((float)(255 - il) * lg);
                        bf16_t* kt = KdT + ((size_t)(head * NCH + u.pm) * 256 + lc) * 256 + il;
                        const u32x4 w1 = pack8(y10 * dk, y11 * dk), w2 = pack8(y20 * dk, y21 * dk);
                        kt[0 * 256] = (bf16_t)(w1.x & 0xffffu); kt[1 * 256] = (bf16_t)(w1.x >> 16); kt[2 * 256] = (bf16_t)(w1.y & 0xffffu); kt[3 * 256] = (bf16_t)(w1.y >> 16);
                        kt[4 * 256] = (bf16_t)(w1.z & 0xffffu); kt[5 * 256] = (bf16_t)(w1.z >> 16); kt[6 * 256] = (bf16_t)(w1.w & 0xffffu); kt[7 * 256] = (bf16_t)(w1.w >> 16);
                        bf16_t* kt2 = kt + 128 * 256;
                        kt2[0 * 256] = (bf16_t)(w2.x & 0xffffu); kt2[1 * 256] = (bf16_t)(w2.x >> 16); kt2[2 * 256] = (bf16_t)(w2.y & 0xffffu); kt2[3 * 256] = (bf16_t)(w2.y >> 16);
                        kt2[4 * 256] = (bf16_t)(w2.z & 0xffffu); kt2[5 * 256] = (bf16_t)(w2.z >> 16); kt2[6 * 256] = (bf16_t)(w2.w & 0xffffu); kt2[7 * 256] = (bf16_t)(w2.w >> 16);
                    }
                    asm volatile("" ::: "memory");
                }
        } else {
            const int act = (pn < 16) ? 0 : (pn < 96) ? 1 : (pn < 112) ? 0 : (pn < 128) ? 1 : 2;
            if (act == 0) {
#pragma unroll
                for (int ai = 0; ai < 2; ++ai)
#pragma unroll
                    for (int m = 0; m < 4; ++m) { const int rg = ROWG(ai, m);
#pragma unroll
                        for (int bj = 0; bj < 2; ++bj) *(u32x4*)(zb + (size_t)rg * LDZ + bj * 128) = pack8(acc[ai][bj][m][0], acc[ai][bj][m][1]); }
            } else {
                const bool is_silu = act == 1;
#pragma unroll
                for (int ai = 0; ai < 2; ++ai)
#pragma unroll
                    for (int m = 0; m < 4; ++m) { const int rg = ROWG(ai, m);
#pragma unroll
                        for (int bj = 0; bj < 2; ++bj) { f32x4 v0 = acc[ai][bj][m][0], v1 = acc[ai][bj][m][1];
#pragma unroll
                            for (int e = 0; e < 4; ++e) { const float s0 = sigm(v0[e]), s1 = sigm(v1[e]); v0[e] = is_silu ? v0[e] * s0 : s0; v1[e] = is_silu ? v1[e] * s1 : s1; }
                            *(u32x4*)(zb + (size_t)rg * LDZ + bj * 128) = pack8(v0, v1); }
                        asm volatile("" ::: "memory"); }
            }
        }
    }
};

struct EpiVt {
    static constexpr bool PERM = true;
    bf16_t* VS;
    __device__ __forceinline__ void operator()(AccRef acc, const Unit& u, int wr, int wc) const {
        const int lane_ = lane_id(), fr = lane_ & 15, fq = lane_ >> 4;
        bf16_t* base = VS + ((size_t)((u.pm >> 1) * NCH + u.pn) * 512 + (u.pm & 1) * 256 + wr * 64 + fr) * 512 + wc * 32 + fq * 8;
#pragma unroll
        for (int ai = 0; ai < 2; ++ai)
#pragma unroll
            for (int m = 0; m < 4; ++m)
#pragma unroll
                for (int bj = 0; bj < 2; ++bj) *(u32x4*)(base + (size_t)(ai * 128 + m * 16) * 512 + bj * 128) = pack8(acc[ai][bj][m][0], acc[ai][bj][m][1]);
    }
};

struct EpiScores {
    static constexpr bool PERM = true;
    bf16_t* PQ;
    __device__ __forceinline__ void operator()(AccRef acc, const Unit& u, int wr, int wc) const {
        const int lane_ = lane_id(), fr = lane_ & 15, fq = lane_ >> 4;
        const float lg = c_lg2g[u.b]; const int lr0 = wr * 64 + fr, lc = wc * 32 + fq * 8;
        bf16_t* base = PQ + ((size_t)u.b * SEQ + u.pm * 256 + lr0) * 512 + lc;
        float gp[8];
#pragma unroll
        for (int e = 0; e < 8; ++e) gp[e] = __builtin_amdgcn_exp2f((float)(7 - e) * lg);
#pragma unroll
        for (int ai = 0; ai < 2; ++ai)
#pragma unroll
            for (int m = 0; m < 4; ++m) { const int rg = ROWG(ai, m);
#pragma unroll
                for (int bj = 0; bj < 2; ++bj) {
                    const int dd = (lr0 + rg) - (lc + bj * 128);
                    const float g0 = __builtin_amdgcn_exp2f((float)(dd - 7) * lg);
                    f32x4 v0 = acc[ai][bj][m][0], v1 = acc[ai][bj][m][1];
#pragma unroll
                    for (int e = 0; e < 4; ++e) { v0[e] = (dd - e) >= 0 ? v0[e] * (g0 * gp[e]) : 0.f; v1[e] = (dd - 4 - e) >= 0 ? v1[e] * (g0 * gp[4 + e]) : 0.f; }
                    *(u32x4*)(base + (size_t)rg * 512 + bj * 128) = pack8(v0, v1);
                }
                asm volatile("" ::: "memory");
            }
    }
};

struct EpiRetOut {
    static constexpr bool PERM = true;
    bf16_t* O; LAS float* rsq;
    __device__ __forceinline__ void operator()(AccRef acc, const Unit& u, int wr, int wc) const {
        const int lane_ = lane_id(), fr = lane_ & 15, fq = lane_ >> 4;
        const int lrow0 = wr * 64 + fr, row0 = u.pm * 256 + lrow0;
        bf16_t* base = O + (size_t)row0 * 8192 + u.b * 512 + u.pn * 256 + wc * 32 + fq * 8;
#pragma unroll
        for (int ai = 0; ai < 2; ++ai)
#pragma unroll
            for (int m = 0; m < 4; ++m) { const int rg = ROWG(ai, m);
                float s = 0.f;
#pragma unroll
                for (int bj = 0; bj < 2; ++bj) { const f32x4 v0 = acc[ai][bj][m][0], v1 = acc[ai][bj][m][1];
                    s += (v0[0] * v0[0] + v0[1] * v0[1]) + (v0[2] * v0[2] + v0[3] * v0[3]) + (v1[0] * v1[0] + v1[1] * v1[1]) + (v1[2] * v1[2] + v1[3] * v1[3]);
                    *(u32x4*)(base + (size_t)rg * 8192 + bj * 128) = pack8(v0, v1); }
                s += shx(s, lane_, 16); s += shx(s, lane_, 32);
                if (fq == 0) (void)__hip_atomic_fetch_add(rsq + u.aux * 256 + lrow0 + rg, s, __ATOMIC_RELAXED, __HIP_MEMORY_SCOPE_WORKGROUP);
                asm volatile("" ::: "memory");
            }
        LDS_WAIT();
    }
};

struct EpiMemS {
    static constexpr bool PERM = true;
    bf16_t* Pm; float* RSm;
    __device__ __forceinline__ void operator()(AccRef acc, const Unit& u, int wr, int wc) const {
        const int lane_ = lane_id(), fr = lane_ & 15, fq = lane_ >> 4;
        const int row0 = u.pm * 256 + wr * 64 + fr;
        bf16_t* base = Pm + ((size_t)u.b * SEQ + row0) * 256 + wc * 32 + fq * 8;
#pragma unroll
        for (int ai = 0; ai < 2; ++ai)
#pragma unroll
            for (int m = 0; m < 4; ++m) { const int rg = ROWG(ai, m);
                float s = 0.f;
#pragma unroll
                for (int bj = 0; bj < 2; ++bj) { f32x4 v0 = acc[ai][bj][m][0], v1 = acc[ai][bj][m][1];
#pragma unroll
                    for (int e = 0; e < 4; ++e) { v0[e] = __builtin_amdgcn_exp2f(fminf(v0[e], 80.f) * 1.44269504f); v1[e] = __builtin_amdgcn_exp2f(fminf(v1[e], 80.f) * 1.44269504f); }
                    const u32x4 w = pack8(v0, v1);
                    s += (bf_lo(w.x) + bf_hi(w.x)) + (bf_lo(w.y) + bf_hi(w.y)) + (bf_lo(w.z) + bf_hi(w.z)) + (bf_lo(w.w) + bf_hi(w.w));
                    *(u32x4*)(base + (size_t)rg * 256 + bj * 128) = w; }
                s += shx(s, lane_, 16); s += shx(s, lane_, 32);
                if (fq == 0) atomic_addf(RSm + (size_t)u.b * SEQ + row0 + rg, s);
                asm volatile("" ::: "memory");
            }
    }
};

struct EpiMemPV {
    static constexpr bool PERM = true;
    const float* RSm; const bf16_t* Zg; bf16_t* Out;
    __device__ __forceinline__ void operator()(AccRef acc, const Unit& u, int wr, int wc) const {
        const int lane_ = lane_id(), fr = lane_ & 15, fq = lane_ >> 4;
        const int row0 = u.pm * 256 + wr * 64 + fr, col0 = u.b * 1024 + u.pn * 256 + wc * 32 + fq * 8;
#pragma unroll
        for (int ai = 0; ai < 2; ++ai)
#pragma unroll
            for (int m = 0; m < 4; ++m) { const int row = row0 + ROWG(ai, m);
                const float rinv = 1.0f / RSm[(size_t)u.b * SEQ + row];
#pragma unroll
                for (int bj = 0; bj < 2; ++bj) { const u32x4 g = *(const u32x4*)(Zg + (size_t)row * LDZ + col0 + bj * 128);
                    *(u32x4*)(Out + (size_t)row * DM + col0 + bj * 128) = pack8(acc[ai][bj][m][0] * rinv * bf4_lo(g), acc[ai][bj][m][1] * rinv * bf4_hi(g)); }
                asm volatile("" ::: "memory"); }
    }
};

struct EpiPool {
    static constexpr bool PERM = true;
    const float* scale; const bf16_t* Zg; bf16_t* Out;
    __device__ __forceinline__ void operator()(AccRef acc, const Unit& u, int wr, int wc) const {
        const int lane_ = lane_id(), fr = lane_ & 15, fq = lane_ >> 4;
        const int row0 = u.pm * 256 + wr * 64 + fr, col0 = u.b * 1024 + u.pn * 256 + wc * 32 + fq * 8;
        f32x4 sc[2][2];
#pragma unroll
        for (int bj = 0; bj < 2; ++bj) { sc[bj][0] = *(const f32x4*)(scale + col0 + bj * 128); sc[bj][1] = *(const f32x4*)(scale + col0 + bj * 128 + 4); }
#pragma unroll
        for (int ai = 0; ai < 2; ++ai)
#pragma unroll
            for (int m = 0; m < 4; ++m) { const int row = row0 + ROWG(ai, m);
#pragma unroll
                for (int bj = 0; bj < 2; ++bj) { const u32x4 g = *(const u32x4*)(Zg + (size_t)row * LDZ + col0 + bj * 128);
                    *(u32x4*)(Out + (size_t)row * DM + col0 + bj * 128) = pack8(acc[ai][bj][m][0] * sc[bj][0] * bf4_lo(g), acc[ai][bj][m][1] * sc[bj][1] * bf4_hi(g)); }
                asm volatile("" ::: "memory"); }
    }
};

struct EpiMerge {
    static constexpr bool PERM = true;
    const bf16_t* Zg; bf16_t* Merged;
    __device__ __forceinline__ bool keep(const Unit& u) const { return u.b != 3; }
    __device__ __forceinline__ void operator()(f32x4 (&acc)[2][2][4][2], const Unit& u, int wr, int wc) const {
        const int seg = u.b; if (seg == 1) return;
        const int lane_ = lane_id(), fr = lane_ & 15, fq = lane_ >> 4;
        const int row0 = u.pm * 256 + wr * 64 + fr, col0 = u.pn * 256 + wc * 32 + fq * 8;
        const int onum = seg == 0 ? 0 : (seg == 2 ? 4096 : 8192), oden = seg == 0 ? 4096 : 8192;
#pragma unroll
        for (int ai = 0; ai < 2; ++ai)
#pragma unroll
            for (int mp = 0; mp < 2; ++mp) {
                int row[2]; u32x4 gn[2][2], gd[2][2];
#pragma unroll
                for (int k = 0; k < 2; ++k) { row[k] = row0 + ROWG(ai, 2 * mp + k);
#pragma unroll
                    for (int bj = 0; bj < 2; ++bj) { const bf16_t* zp = Zg + (size_t)row[k] * LDZ + col0 + bj * 128; gn[k][bj] = *(const u32x4*)(zp + onum); if (seg != 3) gd[k][bj] = *(const u32x4*)(zp + oden); } }
#pragma unroll
                for (int k = 0; k < 2; ++k)
#pragma unroll
                    for (int bj = 0; bj < 2; ++bj) { const int m = 2 * mp + k;
                        f32x4 f0 = bf4_lo(gn[k][bj]), f1 = bf4_hi(gn[k][bj]);
                        if (seg != 3) { const f32x4 d0 = bf4_lo(gd[k][bj]), d1 = bf4_hi(gd[k][bj]);
#pragma unroll
                            for (int e = 0; e < 4; ++e) { f0[e] *= __builtin_amdgcn_rcpf(fmaxf(d0[e], 1e-30f)); f1[e] *= __builtin_amdgcn_rcpf(fmaxf(d1[e], 1e-30f)); } }
                        acc[ai][bj][m][0] *= f0; acc[ai][bj][m][1] *= f1;
                        if (seg == 3) *(u32x4*)(Merged + (size_t)row[k] * DM + col0 + bj * 128) = pack8(acc[ai][bj][m][0], acc[ai][bj][m][1]); }
                asm volatile("" ::: "memory"); }
    }
};

struct EpiOutProj {
    static constexpr bool PERM = false;
    const float* x; float* out; float* RSo;
    __device__ __forceinline__ void operator()(AccRef acc, const Unit& u, int wr, int wc) const {
        const int lane_ = lane_id(), fr = lane_ & 15, fq = lane_ >> 4;
        const int row0 = u.pm * 256 + wr * 64 + fr, col0 = u.pn * 256 + wc * 32 + fq * 4;
#pragma unroll
        for (int ai = 0; ai < 2; ++ai)
#pragma unroll
            for (int m = 0; m < 4; ++m) { const int row = row0 + ROWG(ai, m); float s = 0.f;
#pragma unroll
                for (int bj = 0; bj < 2; ++bj)
#pragma unroll
                    for (int n = 0; n < 2; ++n) { const size_t off = (size_t)row * DM + col0 + bj * 128 + n * 16;
                        const f32x4 v = *(const f32x4*)(x + off) + acc[ai][bj][m][n]; *(f32x4*)(out + off) = v;
                        s += (v[0] * v[0] + v[1] * v[1]) + (v[2] * v[2] + v[3] * v[3]); }
                s += shx(s, lane_, 16); s += shx(s, lane_, 32);
                if (fq == 0) atomic_addf(RSo + row, s);
                asm volatile("" ::: "memory"); }
    }
};
}

#define XB_TMO      128
#define XB_XCNT(j)  (256  + 64 * (j))
#define XB_XSUB(j)  (1280 + 64 * (j))
#define XB_XGEN(j)  (2304 + 64 * (j))
#define XB_TOP      3328
#define XB_TOPGEN   3392
#define XCD_BAR_WORDS 3456
#define XB_SPIN_CAP (1u << 18)
__device__ __forceinline__ unsigned xb_ld(unsigned* p)              { return __hip_atomic_load(p, __ATOMIC_RELAXED, __HIP_MEMORY_SCOPE_AGENT); }
__device__ __forceinline__ unsigned xb_add(unsigned* p, unsigned v) { return __hip_atomic_fetch_add(p, v, __ATOMIC_RELAXED, __HIP_MEMORY_SCOPE_AGENT); }
__device__ __forceinline__ unsigned xb_xcc_id() { return (unsigned)__builtin_amdgcn_s_getreg((3 << 11) | 20) & 0xFu; }
#define XB_SPIN(cond, bar) do { unsigned _sp = 0; while (cond) { __builtin_amdgcn_s_sleep(1); \
    if ((++_sp & 255u) == 0u) { if (xb_ld(&(bar)[XB_TMO])) break; if (_sp > XB_SPIN_CAP) { atomicAdd(&(bar)[XB_TMO], 1u); break; } } } } while (0)
struct XcdBarrier { unsigned* bar; unsigned x; volatile LAS unsigned* st; };
__device__ __forceinline__ XcdBarrier xcd_barrier_post(unsigned* bar, volatile LAS unsigned* st, bool leader) {
    XcdBarrier b; b.bar = bar; b.x = xb_xcc_id(); b.st = st;
    if (leader) (void)xb_add(&bar[XB_XCNT(b.x)], 1u);
    return b;
}
__device__ __forceinline__ void xcd_barrier_complete(unsigned* bar, unsigned x, unsigned& nloc, unsigned& nx) {
    const unsigned G = gridDim.x * gridDim.y * gridDim.z;
    unsigned sum, cnt, mine, sp = 0u;
    for (;;) {
        sum = 0u; cnt = 0u; mine = 0u;
#pragma unroll
        for (unsigned j = 0; j < 16; ++j) { const unsigned c = xb_ld(&bar[XB_XCNT(j)]); sum += c; cnt += (c > 0u) ? 1u : 0u; mine = (j == x) ? c : mine; }
        if (sum == G) break;
        __builtin_amdgcn_s_sleep(1);
        if ((++sp & 255u) == 0u) { if (xb_ld(&bar[XB_TMO])) break; if (sp > XB_SPIN_CAP) { atomicAdd(&bar[XB_TMO], 1u); break; } }
    }
    nloc = mine > 0u ? mine : 1u; nx = cnt > 0u ? cnt : 1u;
}
__device__ __forceinline__ void xcd_barrier(const XcdBarrier& b, bool leader) {
    asm volatile("s_waitcnt vmcnt(0)" ::: "memory");
    __syncthreads();
    if (leader) {
        unsigned* bar = b.bar;
        __builtin_amdgcn_s_waitcnt(0);
        unsigned nloc = b.st[0], nx = b.st[1];
        if (nloc == 0u) { xcd_barrier_complete(bar, b.x, nloc, nx); b.st[0] = nloc; b.st[1] = nx; }
        const unsigned old = xb_add(&bar[XB_XSUB(b.x)], 1u);
        const unsigned gen = old / nloc;
        if (old + 1u == (gen + 1u) * nloc) {
            __builtin_amdgcn_fence(__ATOMIC_RELEASE, "agent");
            asm volatile("s_waitcnt vmcnt(0)" ::: "memory");
            const unsigned og = xb_add(&bar[XB_TOP], 1u);
            const unsigned tg = og / nx;
            if (og + 1u == (tg + 1u) * nx) xb_add(&bar[XB_TOPGEN], 1u);
            else XB_SPIN(xb_ld(&bar[XB_TOPGEN]) == tg, bar);
            __builtin_amdgcn_fence(__ATOMIC_ACQUIRE, "agent");
            xb_add(&bar[XB_XGEN(b.x)], 1u);
            asm volatile("s_waitcnt vmcnt(0)" ::: "memory");
        } else {
            XB_SPIN(xb_ld(&bar[XB_XGEN(b.x)]) == gen, bar);
            __builtin_amdgcn_fence(__ATOMIC_ACQUIRE, "agent");
            asm volatile("s_waitcnt vmcnt(0)" ::: "memory");
        }
    }
    __syncthreads();
}

__device__ __forceinline__ void transpose_item(const float* W, int ldw, int col0, int k0, bf16_t* WT, int ldt, int row0, float scale, LAS float* scr, int lane) {
    const int kr = lane >> 4, n4 = (lane & 15) * 4;
    const float* src = W + (size_t)(k0 + kr) * ldw + col0 + n4;
    f32x4 v[16];
#pragma unroll
    for (int i = 0; i < 16; ++i) v[i] = __builtin_nontemporal_load((const f32x4*)(src + (size_t)(4 * i) * ldw));
#pragma unroll
    for (int i = 0; i < 16; ++i) { LAS float* d = scr + (4 * i + kr) * 65 + n4; d[0] = v[i][0]; d[1] = v[i][1]; d[2] = v[i][2]; d[3] = v[i][3]; }
    LDS_WAIT(); asm volatile("" ::: "memory");
    const int c = lane & 7, nl = lane >> 3;
#pragma unroll
    for (int j = 0; j < 8; ++j) { const int n = nl + 8 * j; const LAS float* q = scr + (8 * c) * 65 + n;
        u32x4 o; o.x = cvt_pk_bf16(q[0 * 65] * scale, q[1 * 65] * scale); o.y = cvt_pk_bf16(q[2 * 65] * scale, q[3 * 65] * scale); o.z = cvt_pk_bf16(q[4 * 65] * scale, q[5 * 65] * scale); o.w = cvt_pk_bf16(q[6 * 65] * scale, q[7 * 65] * scale);
        *(u32x4*)(WT + (size_t)(row0 + n) * ldt + k0 + 8 * c) = o; }
    LDS_WAIT(); asm volatile("" ::: "memory");
}
__device__ __forceinline__ void transpose_job(const float* W, int K, int ldw, int coff, int ncols, bf16_t* WT, int roff, float scale, LAS float* scr, int lane, int gw, int ngw) {
    const int nblk = ncols / 64, items = (K / 64) * nblk;
    for (int it = gw; it < items; it += ngw) { const int kb = it / nblk, nb = it % nblk;
        transpose_item(W, ldw, coff + 64 * nb, 64 * kb, WT, K, roff + 64 * nb, scale, scr, lane); }
}
__device__ __forceinline__ void rms_row_to_bf16(const float* xrow, const float* g, bf16_t* orow, int lane) {
    const f32x4* xr = (const f32x4*)xrow + lane; const f32x4* gr = (const f32x4*)g + lane;
    f32x4 v[16]; float s = 0.f;
#pragma unroll
    for (int j = 0; j < 16; ++j) { v[j] = xr[64 * j]; s += (v[j][0] * v[j][0] + v[j][1] * v[j][1]) + (v[j][2] * v[j][2] + v[j][3] * v[j][3]); }
    const float rstd = 1.0f / sqrtf(wave_sum(s, lane) * (1.0f / DM) + NORM_EPS);
    u32x2* o8 = (u32x2*)orow + lane;
#pragma unroll
    for (int j = 0; j < 16; ++j) { const f32x4 gg = gr[64 * j]; u32x2 w; w.x = cvt_pk_bf16(v[j][0] * rstd * gg[0], v[j][1] * rstd * gg[1]); w.y = cvt_pk_bf16(v[j][2] * rstd * gg[2], v[j][3] * rstd * gg[3]); o8[64 * j] = w; }
}

struct Args { const float* in[14]; float* out; unsigned char* ws; };
#define WSP(type, off) ((type*)(ws + (off)))
__global__ void __launch_bounds__(NWAVES * 64, 2) fwd(Args args) {
    extern __shared__ __attribute__((aligned(16))) unsigned char lds_raw[];
    LAS unsigned char* lds = (LAS unsigned char*)lds_raw;
    const int G = gridDim.x, bx = blockIdx.x;
    unsigned char* const ws = args.ws;
    unsigned* const ctl = (unsigned*)(ws + WS_CTL);
    using pg8::Prob; using pg8::gemm_phase;

    const int wave = __builtin_amdgcn_readfirstlane((int)threadIdx.x >> 6);
    for (int u = threadIdx.x; u < (LDS_BYTES - LDSCTL_OFF) / 4; u += NWAVES * 64) ((LAS unsigned*)(lds + LDSCTL_OFF))[u] = 0u;
    __syncthreads();
    (void)xcd_barrier_post(ctl + CW_BAR, (volatile LAS unsigned*)(lds + MISC_OFF) + 8, wave == 0 && lane_id() == 0);
#define GRID_BAR() do { XcdBarrier _b; _b.bar = (unsigned*)(args.ws + WS_CTL) + CW_BAR; _b.x = xb_xcc_id(); _b.st = (volatile LAS unsigned*)(lds + MISC_OFF) + 8; xcd_barrier(_b, wave == 0 && lane_id() == 0); } while (0)
#define TIDS() const int lane = lane_id(), tid = wave * 64 + lane; \
    const int gw = bx * NWAVES + wave, ngw = G * NWAVES; const size_t gt = (size_t)bx * (NWAVES * 64) + tid, ngt = (size_t)G * (NWAVES * 64); (void)lane; (void)gw; (void)ngw; (void)gt; (void)ngt

    {
        TIDS();
        const float* w_in = args.in[4];
        LAS float* scr = (LAS float*)(lds + wave * TR_TILE_BYTES);
        bf16_t* WtA = WSP(bf16_t, WS_WTA);
        transpose_job(w_in, DM, 53248, 0, 12288, WtA, 0, 1.0f, scr, lane, gw, ngw);
        transpose_job(w_in, DM, 53248, 12288, 4096, WtA, 12288, 0.0625f, scr, lane, gw, ngw);
        transpose_job(w_in, DM, 53248, 16384, 8192, WSP(bf16_t, WS_WTV), 0, 1.0f, scr, lane, gw, ngw);
        transpose_job(w_in, DM, 53248, 24576, 8192, WtA, 16384, 1.0f, scr, lane, gw, ngw);
        transpose_job(w_in, DM, 53248, 32768, 4096, WtA, 24576, 0.03125f, scr, lane, gw, ngw);
        transpose_job(w_in, DM, 53248, 36864, 16384, WtA, 28672, 1.0f, scr, lane, gw, ngw);
#pragma unroll 1
        for (int g = 0; g < 4; ++g) transpose_job(args.in[5] + (size_t)g * 1024 * 1024, 1024, 1024, 0, 1024, WSP(bf16_t, WS_WG) + (size_t)g * 1024 * 1024, 0, 1.0f, scr, lane, gw, ngw);
        transpose_job(args.in[7], DM, DM, 0, DM, WSP(bf16_t, WS_WK), 0, 1.0f, scr, lane, gw, ngw);
        transpose_job(args.in[8], DM, DM, 0, DM, WSP(bf16_t, WS_WV), 0, 1.0f, scr, lane, gw, ngw);
        transpose_job(args.in[9], DM, DM, 0, DM, WSP(bf16_t, WS_WPP), 0, 1.0f, scr, lane, gw, ngw);
        transpose_job(args.in[10], DM, DM, 0, DM, WSP(bf16_t, WS_WPR), 0, 1.0f, scr, lane, gw, ngw);
        transpose_job(args.in[10] + (size_t)DM * DM, DM, DM, 0, DM, WSP(bf16_t, WS_WPR) + (size_t)DM * DM, 0, 1.0f, scr, lane, gw, ngw);
        transpose_job(args.in[11], DM, DM, 0, DM, WSP(bf16_t, WS_WPM), 0, 1.0f, scr, lane, gw, ngw);
        transpose_job(args.in[12], DM, DM, 0, DM, WSP(bf16_t, WS_WO), 0, 1.0f, scr, lane, gw, ngw);
        for (int m = gw; m < SEQ + MEML; m += ngw) {
            if (m < SEQ) rms_row_to_bf16(args.in[0] + (size_t)m * DM, args.in[2], WSP(bf16_t, WS_H) + (size_t)m * DM, lane);
            else rms_row_to_bf16(args.in[1] + (size_t)(m - SEQ) * DM, args.in[3], WSP(bf16_t, WS_MEMN) + (size_t)(m - SEQ) * DM, lane);
        }
        float* ropec = WSP(float, WS_ROPE); float* ropes = ropec + (size_t)SEQ * 128;
        for (size_t i = gt; i < (size_t)SEQ * 128; i += ngt) {
            const int pos = (int)(i >> 7), fi = (int)(i & 127);
            const float ang = (float)pos * c_inv[fi];
            const double rev = (double)ang * 0.15915494309189533577; const float fr_ = (float)(rev - __builtin_rint(rev));
            ropec[i] = __builtin_amdgcn_cosf(fr_); ropes[i] = __builtin_amdgcn_sinf(fr_);
        }
    }
    GRID_BAR();

    {
        { Prob<DM, DM, 8, 0, 0, 512, 0, 256 * DM, 512> p{WSP(bf16_t, WS_MEMN), WSP(bf16_t, WS_WK)}; pg8::BatchOrder S; S.init(8, 1, 16, G, bx);
          pg8::EpiF32Slab E{WSP(float, WS_KMP), DM, MEML * DM, 0, 256}; gemm_phase(lds, wave, p, S, E); }
        { Prob<DM, DM, 8, 256 * DM, 0, 512, 0, 0, 512> p{WSP(bf16_t, WS_WV), WSP(bf16_t, WS_MEMN)}; pg8::BatchOrder S; S.init(8, 16, 1, G, bx >= 128 ? bx - 128 : (1 << 20));
          pg8::EpiF32Slab E{WSP(float, WS_VMTP), 256, MEML * DM, 256 * 256, 0}; gemm_phase(lds, wave, p, S, E); }
        { Prob<DM, DM, DM / 64, 256 * DM, 0, 0, 0, 256 * DM, 0> p{WSP(bf16_t, WS_H), WSP(bf16_t, WS_WTA)}; pg8::StaticOrder S; S.init(SEQ / 256, LDZ / 256, G, bx, 4);
          pg8::EpiMain E{WSP(bf16_t, WS_Z), WSP(bf16_t, WS_PQ), WSP(bf16_t, WS_KDT), WSP(float, WS_ROPE), WSP(float, WS_ROPE) + (size_t)SEQ * 128}; gemm_phase<BIG_ALIGN, BIG_SP2>(lds, wave, p, S, E); }
        { Prob<DM, DM, DM / 64, 256 * DM, 0, 0, 0, 256 * DM, 0> p{WSP(bf16_t, WS_WTV), WSP(bf16_t, WS_H)}; pg8::StaticOrder S; S.init(8192 / 256, SEQ / 256, G, bx);
          pg8::EpiVt E{WSP(bf16_t, WS_VS)}; gemm_phase<BIG_ALIGN, BIG_SP2>(lds, wave, p, S, E); }
    }
    GRID_BAR();

    {
        {
            TIDS();
            const float* slab = WSP(float, WS_KMP); bf16_t* dst = WSP(bf16_t, WS_KM);
            for (size_t i = gt; i < (size_t)2 * MEML * DM / 4; i += ngt) {
                const size_t which = i / (MEML * DM / 4), off = (i % (MEML * DM / 4)) * 4;
                const float* sp = slab + which * ((size_t)8 * MEML * DM) + off;
                f32x4 a = *(const f32x4*)sp;
#pragma unroll
                for (int k = 1; k < 8; ++k) a += *(const f32x4*)(sp + (size_t)k * MEML * DM);
                u32x2 w; w.x = cvt_pk_bf16(a[0], a[1]); w.y = cvt_pk_bf16(a[2], a[3]);
                *(u32x2*)(dst + which * ((size_t)MEML * DM) + off) = w;
            }
        }
        {
            TIDS();
            const bf16_t* Z = WSP(bf16_t, WS_Z); bf16_t* Mixed = WSP(bf16_t, WS_MIXED);
            for (size_t i = gt; i < (size_t)(SEQ / 32) * 512; i += ngt) {
                const int c8 = (int)(i & 511), t0 = (int)(i >> 9) * 32, w = 2 << (c8 >> 7);
                const bf16_t* up = Z + ZO_U + c8 * 8;
                f32x4 s0 = (f32x4){0.f, 0.f, 0.f, 0.f}, s1 = s0;
#pragma unroll
                for (int k = 1; k <= 16; ++k) { const int tr = t0 - k; if (k <= w && tr >= 0) {     const u32x4 v = *(const u32x4*)(up + (size_t)tr * LDZ); s0 += bf4_lo(v); s1 += bf4_hi(v); } }
#pragma unroll 1
                for (int tt = 0; tt < 32; tt += 8) {
                    u32x4 a[8], b[8];
#pragma unroll
                    for (int k = 0; k < 8; ++k) a[k] = *(const u32x4*)(up + (size_t)(t0 + tt + k) * LDZ);
#pragma unroll
                    for (int k = 0; k < 8; ++k) { const int tr = t0 + tt + k - w; b[k] = (u32x4){0u, 0u, 0u, 0u}; if (tr >= 0) b[k] = *(const u32x4*)(up + (size_t)tr * LDZ); }
#pragma unroll
                    for (int k = 0; k < 8; ++k) { const int t = t0 + tt + k; const f32x4 u0 = bf4_lo(a[k]), u1 = bf4_hi(a[k]);
                        s0 += u0 - bf4_lo(b[k]); s1 += u1 - bf4_hi(b[k]);
                        const float rc = 1.0f / (float)((t + 1) < w ? (t + 1) : w);
                        *(u32x4*)(Mixed + (size_t)t * DM + c8 * 8) = pack8(s0 * rc - u0, s1 * rc - u1); }
                }
            }
        }
        { Prob<512, 256, 4, 512 * 512, 256 * 512, NCH * 512 * 512, 256 * 256, 0, NCH * 256 * 256> p{WSP(bf16_t, WS_VS), WSP(bf16_t, WS_KDT)}; pg8::BatchOrder S; S.init(NH, NCH, 2, G, bx);
          pg8::EpiPlain E{WSP(bf16_t, WS_KVT), 256, NCH * 512 * 256, 512 * 256, 256 * 256}; gemm_phase(lds, wave, p, S, E); }
        { Prob<LDZ, LDZ, 4, 256 * LDZ, 0, 256, 256 * LDZ, 0, 256> p{WSP(bf16_t, WS_Z) + ZO_Q, WSP(bf16_t, WS_Z) + ZO_K}; pg8::BatchOrder S; S.init(NH, NCH, 1, G, bx);
          pg8::EpiScores E{WSP(bf16_t, WS_PQ)}; gemm_phase(lds, wave, p, S, E); }
    }
    GRID_BAR();

    {
        {
            TIDS();
            for (size_t i = gt; i < (size_t)NH * 512 * 32; i += ngt) {
                const int d8 = (int)(i & 31), e = (int)((i >> 5) & 511), h = (int)(i >> 14);
                const float gc = __builtin_amdgcn_exp2f(256.0f * c_lg2g[h]);
                f32x4 s0 = (f32x4){0.f, 0.f, 0.f, 0.f}, s1 = s0;
                const bf16_t* kv = WSP(bf16_t, WS_KVT) + ((size_t)(h * NCH) * 512 + e) * 256 + d8 * 8;
                bf16_t* st = WSP(bf16_t, WS_VS) + ((size_t)(h * NCH) * 512 + e) * 512 + 256 + d8 * 8;
#pragma unroll 4
                for (int n = 0; n < NCH; ++n) {
                    *(u32x4*)(st + (size_t)n * 512 * 512) = pack8(s0, s1);
                    const u32x4 v = *(const u32x4*)(kv + (size_t)n * 512 * 256);
                    s0 = s0 * gc + bf4_lo(v); s1 = s1 * gc + bf4_hi(v);
                }
            }
        }
        { Prob<DM, 1024, 16, 256 * DM, 0, 1024, 0, 256 * 1024, 1024 * 1024> p{WSP(bf16_t, WS_MIXED), WSP(bf16_t, WS_WG)}; pg8::BatchOrder S; S.init(4, SEQ / 256, 4, G, bx);
          pg8::EpiPool E{args.in[6], WSP(bf16_t, WS_Z) + ZO_SGP, WSP(bf16_t, WS_POOLOUT)}; gemm_phase(lds, wave, p, S, E); }
        { Prob<LDZ, DM, 16, 256 * LDZ, 0, 1024, 0, 0, 1024> p{WSP(bf16_t, WS_Z) + ZO_QM, WSP(bf16_t, WS_KM)}; pg8::BatchOrder S; S.init(4, SEQ / 256, 1, G, bx);
          pg8::EpiMemS E{WSP(bf16_t, WS_PM), WSP(float, CTL_RSM)}; gemm_phase(lds, wave, p, S, E); }
    }
    GRID_BAR();

    {
        LAS float* rsq = (LAS float*)(lds + LDSCTL_OFF + 2048);
        { TIDS(); for (int i = tid; i < 4 * 256; i += NWAVES * 64) rsq[i] = 0.f; }
        __syncthreads();
        { Prob<512, 512, 8, 256 * 512, 0, SEQ * 512, 512 * 512, 256 * 512, NCH * 512 * 512> p{WSP(bf16_t, WS_PQ), WSP(bf16_t, WS_VS)}; pg8::PairOrder S; S.init(G, bx);
          pg8::EpiRetOut E{WSP(bf16_t, WS_O), rsq}; gemm_phase(lds, wave, p, S, E); }
        {
            TIDS();
            const bf16_t* Ob = WSP(bf16_t, WS_O); const bf16_t* Z = WSP(bf16_t, WS_Z); bf16_t* RetLo = WSP(bf16_t, WS_RETLO);
#pragma unroll 1
            for (int slot = 0; slot * G + bx < NH * NCH && slot < 4; ++slot) {
                const int q = slot * G + bx, pm = q % NCH, h = q / NCH;
#pragma unroll 1
                for (int it0 = tid; it0 < 256 * 64; it0 += 4 * NWAVES * 64) {
                    u32x4 o[4], g[4]; float rs[4];
#pragma unroll
                    for (int k = 0; k < 4; ++k) { const int it = it0 + k * NWAVES * 64, row = it >> 6, c8 = it & 63; const size_t t = (size_t)pm * 256 + row;
                        o[k] = *(const u32x4*)(Ob + t * 8192 + h * 512 + c8 * 8); g[k] = *(const u32x4*)(Z + t * LDZ + ZO_SGR + h * 512 + c8 * 8); rs[k] = rsq[slot * 256 + row]; }
#pragma unroll
                    for (int k = 0; k < 4; ++k) { const int it = it0 + k * NWAVES * 64, row = it >> 6, c8 = it & 63; const size_t t = (size_t)pm * 256 + row;
                        const float rstd = 1.0f / sqrtf(rs[k] * (1.0f / DV) + NORM_EPS);
                        *(u32x4*)(RetLo + (size_t)(h >> 3) * ((size_t)SEQ * DM) + t * DM + (h & 7) * 512 + c8 * 8) = pack8(bf4_lo(o[k]) * rstd * bf4_lo(g[k]), bf4_hi(o[k]) * rstd * bf4_hi(g[k])); }
                }
            }
        }
        { Prob<256, 256, 4, 256 * 256, 0, SEQ * 256, 0, 256 * 256, 1024 * 256> p{WSP(bf16_t, WS_PM), WSP(bf16_t, WS_VMT)}; pg8::BatchOrder S; S.init(4, SEQ / 256, 4, G, bx);
          pg8::EpiMemPV E{WSP(float, CTL_RSM), WSP(bf16_t, WS_Z) + ZO_SGM, WSP(bf16_t, WS_MEMOUT)}; gemm_phase(lds, wave, p, S, E); }
    }
    GRID_BAR();

    {
        Prob<DM, DM, DM / 64, 256 * DM, 0, SEQ * DM, 0, 256 * DM, DM * DM> p{WSP(bf16_t, WS_PROJA), WSP(bf16_t, WS_WPP)}; pg8::MergeOrder S; S.init(SEQ / 256, DM / 256, G, bx);
        pg8::EpiMerge E{WSP(bf16_t, WS_Z) + ZO_AP, WSP(bf16_t, WS_MERGED)}; gemm_phase<true, true, true>(lds, wave, p, S, E);
    }
    GRID_BAR();

    {
        Prob<DM, DM, DM / 64, 256 * DM, 0, 0, 0, 256 * DM, 0> p{WSP(bf16_t, WS_MERGED), WSP(bf16_t, WS_WO)}; pg8::StaticOrder S; S.init(SEQ / 256, DM / 256, G, bx);
        pg8::EpiOutProj E{args.in[0], args.out, WSP(float, CTL_RSO)}; gemm_phase<BIG_ALIGN, BIG_SP2>(lds, wave, p, S, E);
    }
    GRID_BAR();

    {
        TIDS();
        const bool bad = xb_ld(ctl + CW_BAR + XB_TMO) != 0u;
        const float* RSo = WSP(float, CTL_RSO); const float* norm_f = args.in[13]; float* out = args.out;
        const float qn = __builtin_nanf("");
        for (size_t i0 = gt; i0 < (size_t)SEQ * 1024; i0 += 4 * ngt) {
            f32x4 v[4], nf[4]; float rs[4];
#pragma unroll
            for (int k = 0; k < 4; ++k) { const size_t i = i0 + k * ngt; if (i < (size_t)SEQ * 1024) { const int c4 = (int)(i & 1023), t = (int)(i >> 10);
                v[k] = *(const f32x4*)(out + (size_t)t * DM + c4 * 4); nf[k] = *(const f32x4*)(norm_f + c4 * 4); rs[k] = RSo[t]; } }
#pragma unroll
            for (int k = 0; k < 4; ++k) { const size_t i = i0 + k * ngt; if (i < (size_t)SEQ * 1024) { const int c4 = (int)(i & 1023), t = (int)(i >> 10);
                const float rstd = 1.0f / sqrtf(rs[k] * (1.0f / DM) + NORM_EPS);
                f32x4 r = v[k] * rstd * nf[k]; if (bad) r = (f32x4){qn, qn, qn, qn};
                *(f32x4*)(out + (size_t)t * DM + c4 * 4) = r; } }
        }
    }
}

extern "C" void kernel_launch(void* const* d_in, const int* in_sizes, int n_in, void* d_out, int out_size, void* d_ws, size_t ws_size, hipStream_t stream) {
    static int grid = 0;
    if (grid == 0) {
        if (n_in != 14 || out_size != SEQ * DM || ws_size < WS_END) { fprintf(stderr, "kernel_launch: unexpected shapes (n_in %d, out %d, ws %zu < %zu); nothing launched\n", n_in, out_size, ws_size, (size_t)WS_END); grid = -1; return; }
        int dev = 0, cus = 0, per_cu = 0;
        if (hipGetDevice(&dev) != hipSuccess || hipDeviceGetAttribute(&cus, hipDeviceAttributeMultiprocessorCount, dev) != hipSuccess) { grid = -1; return; }
        if (hipFuncSetAttribute((const void*)fwd, hipFuncAttributeMaxDynamicSharedMemorySize, LDS_BYTES) != hipSuccess) { fprintf(stderr, "kernel_launch: hipFuncSetAttribute failed\n"); grid = -1; return; }
        if (hipOccupancyMaxActiveBlocksPerMultiprocessor(&per_cu, (const void*)fwd, NWAVES * 64, LDS_BYTES) != hipSuccess || per_cu < 1) fprintf(stderr, "kernel_launch: occupancy query reports %d\n", per_cu);
        (void)hipGetLastError();
        grid = cus;
    }
    if (grid < 0) return;
    (void)in_sizes;
    if (hipMemsetAsync((char*)d_ws + WS_CTL, 0, CTL_ZERO_BYTES, stream) != hipSuccess) return;
    Args a{};
    for (int i = 0; i < 14; ++i) a.in[i] = (const float*)d_in[i];
    a.out = (float*)d_out; a.ws = (unsigned char*)d_ws;
    hipLaunchKernelGGL(fwd, dim3(grid), dim3(NWAVES * 64), LDS_BYTES, stream, a);
}
```
